# Optimizing an MI355X kernel written in HIP

```python
import jax, jax.numpy as jnp
from jax import lax
import numpy as np

D_MODEL = 2048
BATCH = 2
SEQ = 8192
DEPTH = 2

N_MIXERS = 2
HEAD_DIM = 128
EPS = 1e-6
FOX_HEADS = D_MODEL // HEAD_DIM
FOX_BLOCK = 128
DIL_PATTERNS = ((128, 1), (512, 4), (2048, 16))
N_GROUPS = len(DIL_PATTERNS)
DIL_SPAN = 128
DIL_HEADS = D_MODEL // (2 * HEAD_DIM)
DIL_V_DIM = D_MODEL // DIL_HEADS
ALIBI_MAX_EXP = 8.0
D_FF = 4 * D_MODEL
N_FOX_LAYERS = (DEPTH + 1) // 2
N_DIL_LAYERS = DEPTH // 2

kernel_name = "fox_dilated_hybrid_trunk"


def rms_norm(x, g):
    xf = x.astype(jnp.float32)
    y = xf * lax.rsqrt(jnp.mean(xf * xf, axis=-1, keepdims=True) + EPS)
    return (y * g.astype(jnp.float32)).astype(x.dtype)


def sq_relu_mlp(h, w_up, w_down):
    a = jax.nn.relu(h @ w_up)
    return (a * a) @ w_down


def fox_attention(h, w_in, b_f, q_gain, k_gain, w_out):
    B, S, _ = h.shape
    H, dh = FOX_HEADS, HEAD_DIM
    proj = h @ w_in
    q, k, v, f = jnp.split(proj, [H * dh, 2 * H * dh, 3 * H * dh], axis=-1)
    q = rms_norm(q.reshape(B, S, H, dh), q_gain)
    k = rms_norm(k.reshape(B, S, H, dh), k_gain)
    v = v.reshape(B, S, H, dh)
    log_f = jax.nn.log_sigmoid((f + b_f).astype(jnp.float32))
    c = jnp.cumsum(log_f, axis=1)
    c_keys = jnp.transpose(c, (0, 2, 1))
    nb = S // FOX_BLOCK
    qb = jnp.moveaxis(q.reshape(B, nb, FOX_BLOCK, H, dh), 1, 0)
    cb = jnp.moveaxis(c.reshape(B, nb, FOX_BLOCK, H), 1, 0)
    kpos = jnp.arange(S)
    scale = dh ** -0.5

    def one_block(args):
        i, q_i, c_i = args
        s = jnp.einsum('bqhd,bkhd->bhqk', q_i, k, preferred_element_type=jnp.float32) * scale
        s = s + jnp.transpose(c_i, (0, 2, 1))[..., None] - c_keys[:, :, None, :]
        qpos = i * FOX_BLOCK + jnp.arange(FOX_BLOCK)
        causal = kpos[None, :] <= qpos[:, None]
        s = jnp.where(causal, s, -jnp.inf)
        p = jax.nn.softmax(s, axis=-1)
        return jnp.einsum('bhqk,bkhd->bqhd', p.astype(v.dtype), v)

    o = lax.map(one_block, (jnp.arange(nb), qb, cb))
    o = jnp.moveaxis(o, 0, 1).reshape(B, S, H * dh)
    return o @ w_out


def dilated_group(q, k, v, slopes, r):
    B, S, H, dh = q.shape
    L = S // r
    nb = -(-L // DIL_SPAN)
    Lp = nb * DIL_SPAN

    def to_blocks(t):
        t = t.reshape((B, L, r) + t.shape[2:])
        t = jnp.moveaxis(t, 2, 1)
        t = jnp.pad(t, [(0, 0), (0, 0), (0, Lp - L)] + [(0, 0)] * (t.ndim - 3))
        return t.reshape((B, r, nb, DIL_SPAN) + t.shape[3:])

    def with_prev(t):
        prev = jnp.pad(t, [(0, 0), (0, 0), (1, 0)] + [(0, 0)] * (t.ndim - 3))[:, :, :-1]
        return jnp.concatenate([prev, t], axis=3)

    def from_blocks(t):
        t = t.reshape((B, r, Lp) + t.shape[4:])[:, :, :L]
        t = jnp.moveaxis(t, 1, 2)
        return t.reshape((B, S) + t.shape[3:])

    qb = to_blocks(q)
    kw = with_prev(to_blocks(k))
    vw = with_prev(to_blocks(v))
    s = jnp.einsum('brnqhd,brnkhd->brnhqk', qb, kw, preferred_element_type=jnp.float32) * dh ** -0.5
    qi = jnp.arange(DIL_SPAN)[:, None]
    kj = jnp.arange(2 * DIL_SPAN)[None, :]
    delta = qi + DIL_SPAN - kj
    blk = jnp.arange(nb)[:, None, None]
    valid = (delta >= 0) & (delta <= DIL_SPAN) & ((blk > 0) | (kj >= DIL_SPAN))
    alibi = -slopes.astype(jnp.float32)[:, None, None] * (delta * r).astype(jnp.float32)
    s = jnp.where(valid[None, None, :, None], s + alibi, -jnp.inf)
    m = jnp.max(s, axis=-1)
    p = jnp.exp(s - m[..., None])
    den = jnp.sum(p, axis=-1)
    num = jnp.einsum('brnhqk,brnkhd->brnqhd', p, vw.astype(jnp.float32))
    return (from_blocks(jnp.swapaxes(m, 3, 4)),
            from_blocks(jnp.swapaxes(den, 3, 4)),
            from_blocks(num))


def dilated_attention(h, w_in, q_gain, k_gain, w_out):
    B, S, _ = h.shape
    G, H, dh, dv = N_GROUPS, DIL_HEADS, HEAD_DIM, DIL_V_DIM
    proj = h @ w_in
    q, k, v = jnp.split(proj, [G * H * dh, 2 * G * H * dh], axis=-1)
    q = rms_norm(q.reshape(B, S, G, H, dh), q_gain[:, None, :])
    k = rms_norm(k.reshape(B, S, G, H, dh), k_gain[:, None, :])
    v = v.reshape(B, S, H, dv)
    slopes = jnp.exp2(-ALIBI_MAX_EXP * jnp.arange(1, G * H + 1, dtype=jnp.float32) / (G * H)).reshape(G, H)
    ms, dens, nums = [], [], []
    for g, (window, r) in enumerate(DIL_PATTERNS):
        m_g, den_g, num_g = dilated_group(q[:, :, g], k[:, :, g], v, slopes[g], r)
        ms.append(m_g); dens.append(den_g); nums.append(num_g)
    m_all = jnp.stack(ms, 0)
    w = jnp.exp(m_all - jnp.max(m_all, axis=0, keepdims=True))
    den = jnp.sum(w * jnp.stack(dens, 0), axis=0)
    num = jnp.sum(w[..., None] * jnp.stack(nums, 0), axis=0)
    o = (num / den[..., None]).reshape(B, S, H * dv).astype(h.dtype)
    return o @ w_out


def setup_inputs(seed: int = 0) -> dict:
    key = jax.random.key(seed)
    ks = jax.random.split(key, 16)
    D = D_MODEL
    nrm = lambda k, shape, fan_in: jax.random.normal(k, shape, jnp.float32) * fan_in ** -0.5
    x = jax.random.normal(ks[0], (BATCH, SEQ, D), jnp.float32)
    fox_qkv = nrm(ks[1], (N_FOX_LAYERS, D, 3 * FOX_HEADS * HEAD_DIM), D)
    fox_fg = 0.1 * nrm(ks[2], (N_FOX_LAYERS, D, FOX_HEADS), D)
    fox_w_in = jnp.concatenate([fox_qkv, fox_fg], axis=-1)
    fox_b_f = 3.0 + 0.1 * jax.random.normal(ks[3], (N_FOX_LAYERS, FOX_HEADS), jnp.float32)
    fox_q_gain = 1.0 + 0.02 * jax.random.normal(ks[4], (N_FOX_LAYERS, HEAD_DIM), jnp.float32)
    fox_k_gain = 1.0 + 0.02 * jax.random.normal(ks[5], (N_FOX_LAYERS, HEAD_DIM), jnp.float32)
    fox_w_out = nrm(ks[6], (N_FOX_LAYERS, FOX_HEADS * HEAD_DIM, D), FOX_HEADS * HEAD_DIM)
    dil_cols = 2 * N_GROUPS * DIL_HEADS * HEAD_DIM + DIL_HEADS * DIL_V_DIM
    dil_w_in = nrm(ks[7], (N_DIL_LAYERS, D, dil_cols), D)
    dil_q_gain = 1.0 + 0.02 * jax.random.normal(ks[8], (N_DIL_LAYERS, N_GROUPS, HEAD_DIM), jnp.float32)
    dil_k_gain = 1.0 + 0.02 * jax.random.normal(ks[9], (N_DIL_LAYERS, N_GROUPS, HEAD_DIM), jnp.float32)
    dil_w_out = nrm(ks[10], (N_DIL_LAYERS, DIL_HEADS * DIL_V_DIM, D), DIL_HEADS * DIL_V_DIM)
    mix_norm_g = 1.0 + 0.02 * jax.random.normal(ks[11], (DEPTH, D), jnp.float32)
    mlp_norm_g = 1.0 + 0.02 * jax.random.normal(ks[12], (DEPTH, D), jnp.float32)
    mlp_w_up = nrm(ks[13], (DEPTH, D, D_FF), D)
    mlp_w_down = nrm(ks[14], (DEPTH, D_FF, D), D_FF)
    return {"x": x, "fox_w_in": fox_w_in, "fox_b_f": fox_b_f, "fox_q_gain": fox_q_gain,
            "fox_k_gain": fox_k_gain, "fox_w_out": fox_w_out, "dil_w_in": dil_w_in,
            "dil_q_gain": dil_q_gain, "dil_k_gain": dil_k_gain, "dil_w_out": dil_w_out,
            "mix_norm_g": mix_norm_g, "mlp_norm_g": mlp_norm_g,
            "mlp_w_up": mlp_w_up, "mlp_w_down": mlp_w_down}


def reference(x, fox_w_in, fox_b_f, fox_q_gain, fox_k_gain, fox_w_out, dil_w_in,
              dil_q_gain, dil_k_gain, dil_w_out, mix_norm_g, mlp_norm_g, mlp_w_up, mlp_w_down):
    for i in range(DEPTH):
        j = i // N_MIXERS
        h = rms_norm(x, mix_norm_g[i])
        if i % N_MIXERS == 0:
            mix = fox_attention(h, fox_w_in[j], fox_b_f[j], fox_q_gain[j], fox_k_gain[j], fox_w_out[j])
        else:
            mix = dilated_attention(h, dil_w_in[j], dil_q_gain[j], dil_k_gain[j], dil_w_out[j])
        x = x + mix.astype(x.dtype)
        h = rms_norm(x, mlp_norm_g[i])
        x = x + sq_relu_mlp(h, mlp_w_up[i], mlp_w_down[i]).astype(x.dtype)
    return x
```

```cpp
#include <hip/hip_runtime.h>
#include <hip/hip_cooperative_groups.h>
#include <cstdio>
#include <cstdint>
#include <cmath>
namespace cg = cooperative_groups;
namespace pg8 {
#define PG8_LAS __attribute__((address_space(3)))
typedef unsigned short bf16_t;
typedef short bf16x8 __attribute__((ext_vector_type(8)));
typedef float f32x4 __attribute__((ext_vector_type(4)));
typedef unsigned u32x4 __attribute__((ext_vector_type(4)));
constexpr int BM = 256, BK = 64, HALF = 128, HTB = HALF * BK * 2  , STAGE_BYTES = 8 * HTB, NXCD = 8, WGM = 8;

__host__ __device__ __forceinline__ int lds_byte(int r, int c) { const int st = (r >> 4) * 2 + (c >> 5), rr = r & 15, cc = c & 31, ob = rr * 64 + cc * 2; return st * 1024 + (ob ^ (((ob >> 9) & 1) << 5)); }
__host__ __device__ __forceinline__ void stage_rc(int b, int& R, int& C) { const int st = b / 1024, sb = b % 1024, swz = sb ^ (((sb >> 9) & 1) << 5); R = (st >> 1) * 16 + swz / 64; C = (st & 1) * 32 + (swz % 64) / 2; }
__host__ __device__ __forceinline__ int perm32(int rho) { const int n = rho >> 4, i = rho & 15; return 8 * (i >> 2) + 4 * n + (i & 3); }

struct Unit { int pm, pn; };
struct Gemm { const bf16_t* A; const bf16_t* Bt; int M, N, K; };

struct StaticOrder {
    int nM, nN, nwg, G, c;
    __host__ __device__ void init(int M, int N, int G_, int c_) { nM = M / BM; nN = N / BM; nwg = nM * nN; G = G_; c = c_; }
    __host__ __device__ bool next(int i, Unit& u) const {
        const long L = (long)i * G + c; if (L >= nwg) return false;
        int wgid = (int)L; { const int q = nwg / NXCD, r = nwg % NXCD, xcd = wgid % NXCD, off = wgid / NXCD; wgid = (xcd < r ? xcd * (q + 1) : r * (q + 1) + (xcd - r) * q) + off; }
        const int nig = WGM * nN, gid = wgid / nig, fm = gid * WGM, gsz = (nM - fm) < WGM ? (nM - fm) : WGM;
        u.pm = fm + ((wgid % nig) % gsz); u.pn = (wgid % nig) / gsz; return true;
    }
    __device__ __forceinline__ void a_ready(const Unit&) const {}
    __device__ __forceinline__ void done(const Unit&) const {}
};

__device__ __forceinline__ unsigned cvt_pk_bf16(float lo, float hi) { unsigned r; asm volatile("v_cvt_pk_bf16_f32 %0, %1, %2" : "=v"(r) : "v"(lo), "v"(hi)); return r; }
typedef float f32x2 __attribute__((ext_vector_type(2)));
constexpr int TOK = 16384;
__device__ __forceinline__ float sq4(f32x4 v) { return (v[0] * v[0] + v[1] * v[1]) + (v[2] * v[2] + v[3] * v[3]); }
__device__ __forceinline__ bool epi_rs_table(PG8_LAS float* RS, PG8_LAS unsigned char* ex, const float* ssp, int pm) {
    const int tid = threadIdx.x;
    if (*(volatile PG8_LAS int*)(ex + 12288) == pm) return false;
    if (tid < 256) { float s = 0.f;
#pragma unroll
        for (int i = 0; i < 8; ++i) s += ssp[(size_t)i * TOK + pm * BM + tid];
        RS[tid] = rsqrtf(s * (1.0f / 2048.0f) + 1e-6f); }
    return true;
}
__device__ __forceinline__ void epi_rs_commit(PG8_LAS unsigned char* ex, int pm) { if (threadIdx.x == 0) *(volatile PG8_LAS int*)(ex + 12288) = pm; }
__device__ __forceinline__ void epi_rs_invalidate(PG8_LAS unsigned char* ex) { if (threadIdx.x == 0) *(volatile PG8_LAS int*)(ex + 12288) = -1; }
#define EPI_SYNC() do { asm volatile("s_waitcnt lgkmcnt(0)" ::: "memory"); __builtin_amdgcn_s_barrier(); asm volatile("" ::: "memory"); } while (0)

struct EpiQKV {
    static constexpr bool PERM = true, AFTER_DRAIN = false;
    bf16_t *Q, *Kb, *V; int nq, pitch_qk; const float *gq, *gk; int gain_tiles; const float* ssp; PG8_LAS unsigned char* ex;
    __device__ __forceinline__ void operator()(const f32x4 (&acc)[2][2][4][2], const Unit& u, int wr, int wc, int fr, int fq) const {
        PG8_LAS float* RS = (PG8_LAS float*)ex; PG8_LAS float* P = (PG8_LAS float*)(ex + 1024);
        const bool fresh = epi_rs_table(RS, ex, ssp, u.pm);
        const bool isV = u.pn >= 2 * nq;
        if (!isV) {
#pragma unroll
            for (int ai = 0; ai < 2; ++ai)
#pragma unroll
                for (int m = 0; m < 4; ++m)
#pragma unroll
                    for (int bj = 0; bj < 2; ++bj) { float q = sq4(acc[ai][bj][m][0]) + sq4(acc[ai][bj][m][1]); q += __shfl_xor(q, 16); q += __shfl_xor(q, 32);
                        if (fq == 0) P[((ai * HALF + wr * 64 + m * 16 + fr) * 2 + bj) * 4 + wc] = q; }
        }
        if (fresh || !isV) EPI_SYNC();
        if (fresh) epi_rs_commit(ex, u.pm);
        const int d0 = wc * 32 + 8 * fq;
        if (isV) {
            const int colt = (u.pn - 2 * nq) * BM + d0;
#pragma unroll
            for (int ai = 0; ai < 2; ++ai)
#pragma unroll
                for (int m = 0; m < 4; ++m) { const int rl = ai * HALF + wr * 64 + m * 16 + fr; const float rs = RS[rl]; bf16_t* rowp = V + (size_t)(u.pm * BM + rl) * 2048 + colt;
#pragma unroll
                    for (int bj = 0; bj < 2; ++bj) { const f32x4 v0 = acc[ai][bj][m][0] * rs, v1 = acc[ai][bj][m][1] * rs; u32x4 w;
                        w.x = cvt_pk_bf16(v0[0], v0[1]); w.y = cvt_pk_bf16(v0[2], v0[3]); w.z = cvt_pk_bf16(v1[0], v1[1]); w.w = cvt_pk_bf16(v1[2], v1[3]); *(u32x4*)(rowp + bj * HALF) = w; } }
        } else {
            const bool isQ = u.pn < nq; const int tp = isQ ? u.pn : u.pn - nq; const float* gp = (isQ ? gq : gk) + (tp / gain_tiles) * 128 + d0;
            const float qs = isQ ? 0.08838834764831845f * 1.4426950408889634f : 1.0f;
            const f32x4 g0 = *(const f32x4*)gp * qs, g1 = *(const f32x4*)(gp + 4) * qs;
            bf16_t* base = (isQ ? Q : Kb) + tp * BM + d0;
#pragma unroll
            for (int ai = 0; ai < 2; ++ai)
#pragma unroll
                for (int m = 0; m < 4; ++m) { const int rl = ai * HALF + wr * 64 + m * 16 + fr; const float rs = RS[rl]; bf16_t* rowp = base + (size_t)(u.pm * BM + rl) * pitch_qk;
#pragma unroll
                    for (int bj = 0; bj < 2; ++bj) { const f32x4 pp = *(const PG8_LAS f32x4*)(P + (rl * 2 + bj) * 4); const float tot = (pp[0] + pp[1]) + (pp[2] + pp[3]);
                        const float f = rs * rsqrtf(rs * rs * tot * (1.0f / 128.0f) + 1e-6f);
                        const f32x4 v0 = acc[ai][bj][m][0] * f * g0, v1 = acc[ai][bj][m][1] * f * g1; u32x4 w;
                        w.x = cvt_pk_bf16(v0[0], v0[1]); w.y = cvt_pk_bf16(v0[2], v0[3]); w.z = cvt_pk_bf16(v1[0], v1[1]); w.w = cvt_pk_bf16(v1[2], v1[3]); *(u32x4*)(rowp + bj * HALF) = w; } }
        }
    }
};
struct EpiUp {
    static constexpr bool PERM = true, AFTER_DRAIN = false;
    bf16_t* H; const float* ssp; PG8_LAS unsigned char* ex;
    __device__ __forceinline__ void operator()(const f32x4 (&acc)[2][2][4][2], const Unit& u, int wr, int wc, int fr, int fq) const {
        PG8_LAS float* RS = (PG8_LAS float*)ex;
        if (epi_rs_table(RS, ex, ssp, u.pm)) { EPI_SYNC(); epi_rs_commit(ex, u.pm); }
        const int col0 = u.pn * BM + wc * 32 + 8 * fq;
#pragma unroll
        for (int ai = 0; ai < 2; ++ai)
#pragma unroll
            for (int m = 0; m < 4; ++m) { const int rl = ai * HALF + wr * 64 + m * 16 + fr; const float rs = RS[rl]; bf16_t* rowp = H + (size_t)(u.pm * BM + rl) * 8192 + col0;
#pragma unroll
                for (int bj = 0; bj < 2; ++bj) { f32x4 v0 = acc[ai][bj][m][0] * rs, v1 = acc[ai][bj][m][1] * rs;
#pragma unroll
                    for (int j = 0; j < 4; ++j) { v0[j] = fmaxf(v0[j], 0.f); v1[j] = fmaxf(v1[j], 0.f); }
                    v0 = v0 * v0; v1 = v1 * v1; u32x4 w;
                    w.x = cvt_pk_bf16(v0[0], v0[1]); w.y = cvt_pk_bf16(v0[2], v0[3]); w.z = cvt_pk_bf16(v1[0], v1[1]); w.w = cvt_pk_bf16(v1[2], v1[3]); *(u32x4*)(rowp + bj * HALF) = w; } }
    }
};
struct EpiRes {
    static constexpr bool PERM = true, AFTER_DRAIN = false;
    const bf16_t* base; float* out; bf16_t* xb; float* ssp; PG8_LAS unsigned char* ex;
    __device__ __forceinline__ void operator()(const f32x4 (&acc)[2][2][4][2], const Unit& u, int wr, int wc, int fr, int fq) const {
        PG8_LAS float* P = (PG8_LAS float*)(ex + 1024);
        const int col0 = u.pn * BM + wc * 32 + 8 * fq;
#pragma unroll
        for (int ai = 0; ai < 2; ++ai)
#pragma unroll
            for (int m = 0; m < 4; ++m) { const int rl = ai * HALF + wr * 64 + m * 16 + fr; const size_t off = (size_t)(u.pm * BM + rl) * 2048 + col0; float q = 0.f;
#pragma unroll
                for (int bj = 0; bj < 2; ++bj) { const u32x4 bw = *(const u32x4*)(base + off + bj * HALF);
                    f32x4 v0, v1;
                    v0[0] = __builtin_bit_cast(float, bw.x << 16); v0[1] = __builtin_bit_cast(float, bw.x & 0xffff0000u); v0[2] = __builtin_bit_cast(float, bw.y << 16); v0[3] = __builtin_bit_cast(float, bw.y & 0xffff0000u);
                    v1[0] = __builtin_bit_cast(float, bw.z << 16); v1[1] = __builtin_bit_cast(float, bw.z & 0xffff0000u); v1[2] = __builtin_bit_cast(float, bw.w << 16); v1[3] = __builtin_bit_cast(float, bw.w & 0xffff0000u);
                    v0 = v0 + acc[ai][bj][m][0]; v1 = v1 + acc[ai][bj][m][1];
                    if (out) { *(f32x4*)(out + off + bj * HALF) = v0; *(f32x4*)(out + off + bj * HALF + 4) = v1; }
                    q += sq4(v0) + sq4(v1);
                    if (xb) { u32x4 w; w.x = cvt_pk_bf16(v0[0], v0[1]); w.y = cvt_pk_bf16(v0[2], v0[3]); w.z = cvt_pk_bf16(v1[0], v1[1]); w.w = cvt_pk_bf16(v1[2], v1[3]); *(u32x4*)(xb + off + bj * HALF) = w; } }
                q += __shfl_xor(q, 16); q += __shfl_xor(q, 32);
                if (fq == 0) P[rl * 4 + wc] = q; }
        EPI_SYNC();
        const int tid = threadIdx.x;
        if (tid < 256) { const f32x4 pp = *(const PG8_LAS f32x4*)(P + tid * 4); ssp[(size_t)u.pn * TOK + u.pm * BM + tid] = (pp[0] + pp[1]) + (pp[2] + pp[3]); }
    }
};

template <class Epi, class Sched, bool ALIGN_EPI = false, bool SP2 = false>
__device__ __forceinline__ void gemm_phase(PG8_LAS unsigned char* lds, const Gemm g, const Sched& S, const Epi& E) {
    int tid_ = threadIdx.x; asm volatile("" : "+v"(tid_));
    const int tid = tid_, wid = __builtin_amdgcn_readfirstlane(tid >> 6), lane = tid & 63, wr = wid >> 2, wc = wid & 3, fr = lane & 15, fq = lane >> 4;
    const int K = g.K, nt = K / BK;
    unsigned voffA[2], voffB[2];
#pragma unroll
    for (int i = 0; i < 2; ++i) { int R, C; stage_rc(tid * 16 + i * 8192, R, C); const int Rb = Epi::PERM ? ((R & ~31) + perm32(R & 31)) : R;
        voffA[i] = (unsigned)(R * K + C) * 2u; voffB[i] = (unsigned)(Rb * K + C) * 2u; }
    const size_t kstep = (size_t)(BK * 2);
    const size_t hstep = (size_t)HALF * K * 2;
    const size_t tstep = 2 * hstep;
    const unsigned ldsw = (unsigned)wid * 1024u;
    const int aoff = lds_byte(wr * 64 + fr, fq * 8), boff = lds_byte(wc * 32 + fr, fq * 8);
#define PG8_SA(b, h) (((b) * 2 + (h)) * HTB)
#define PG8_SB(b, h) ((4 + (b) * 2 + (h)) * HTB)
#define PG8_STAGE(bufoff, gbase, voff) do { _Pragma("unroll") for (int _i = 0; _i < 2; ++_i) \
        __builtin_amdgcn_global_load_lds((const unsigned*)((const char*)(gbase) + (voff)[_i]), (PG8_LAS unsigned*)(lds + (bufoff) + ldsw + _i * 8192), 16, 0, 0); } while (0)
#define PG8_LDA(dst, b, h) do { _Pragma("unroll") for (int m = 0; m < 4; ++m) _Pragma("unroll") for (int k = 0; k < 2; ++k) dst[m][k] = *(const PG8_LAS bf16x8*)(lds + PG8_SA(b, h) + aoff + m * 2048 + k * 1024); } while (0)
#define PG8_LDB(dst, b, h) do { _Pragma("unroll") for (int n = 0; n < 2; ++n) _Pragma("unroll") for (int k = 0; k < 2; ++k) dst[n][k] = *(const PG8_LAS bf16x8*)(lds + PG8_SB(b, h) + boff + n * 2048 + k * 1024); } while (0)
#define PG8_MMA(ai, bj, At, Bt) do { __builtin_amdgcn_s_setprio(1); _Pragma("unroll") for (int m = 0; m < 4; ++m) _Pragma("unroll") for (int n = 0; n < 2; ++n) _Pragma("unroll") for (int k = 0; k < 2; ++k) \
        acc[ai][bj][m][n] = __builtin_amdgcn_mfma_f32_16x16x32_bf16(Bt[n][k], At[m][k], acc[ai][bj][m][n], 0, 0, 0); __builtin_amdgcn_s_setprio(0); } while (0)
#define PG8_WAIT_V(n) asm volatile("s_waitcnt vmcnt(" #n ")" ::: "memory")
#define PG8_WAIT_L(n) asm volatile("s_waitcnt lgkmcnt(" #n ")" ::: "memory")
#define PG8_BAR __builtin_amdgcn_s_barrier()
#define PG8_SCHED __builtin_amdgcn_sched_barrier(0)
    Unit cur, nxt; int ui = 0;
    if (!S.next(0, cur)) return;
    f32x4 acc[2][2][4][2];
#pragma unroll
    for (int a = 0; a < 2; ++a)
#pragma unroll
        for (int b = 0; b < 2; ++b)
#pragma unroll
            for (int m = 0; m < 4; ++m)
#pragma unroll
                for (int n = 0; n < 2; ++n) acc[a][b][m][n] = (f32x4){0.f, 0.f, 0.f, 0.f};
    bf16x8 At[4][2], B0[2][2], B1[2][2];
    const char* cA = (const char*)g.A + (size_t)cur.pm * tstep; const char* cB = (const char*)g.Bt + (size_t)cur.pn * tstep;
    S.a_ready(cur);
    if constexpr (SP2) {
        PG8_STAGE(PG8_SB(0, 0), cB, voffB); PG8_STAGE(PG8_SB(0, 1), cB + hstep, voffB); PG8_STAGE(PG8_SA(0, 0), cA, voffA); PG8_STAGE(PG8_SA(0, 1), cA + hstep, voffA);
        if (wr == 1) PG8_BAR;
        PG8_WAIT_V(2); PG8_BAR;
        PG8_STAGE(PG8_SB(1, 0), cB + kstep, voffB); PG8_STAGE(PG8_SA(1, 0), cA + kstep, voffA); PG8_STAGE(PG8_SB(1, 1), cB + hstep + kstep, voffB);
        PG8_WAIT_V(6); PG8_BAR;
    } else {
        PG8_STAGE(PG8_SB(0, 0), cB, voffB); PG8_STAGE(PG8_SA(0, 0), cA, voffA); PG8_STAGE(PG8_SB(0, 1), cB + hstep, voffB); PG8_STAGE(PG8_SA(0, 1), cA + hstep, voffA);
        if (wr == 1) PG8_BAR;
        PG8_WAIT_V(4); PG8_BAR;
        PG8_STAGE(PG8_SB(1, 0), cB + kstep, voffB); PG8_STAGE(PG8_SA(1, 0), cA + kstep, voffA); PG8_STAGE(PG8_SB(1, 1), cB + hstep + kstep, voffB);
        PG8_WAIT_V(6); PG8_BAR;
    }
    for (;;) {
        const bool has_next = S.next(ui + 1, nxt);
        const char* nA = has_next ? (const char*)g.A + (size_t)nxt.pm * tstep : cA; const char* nB = has_next ? (const char*)g.Bt + (size_t)nxt.pn * tstep : cB;
        for (int t = 0; t < nt; t += 2) {
            const bool last = (t == nt - 2);
            const char* a1 = cA + (size_t)(t + 1) * kstep;
            const char* a2 = last ? nA : cA + (size_t)(t + 2) * kstep; const char* b2 = last ? nB : cB + (size_t)(t + 2) * kstep;
            const char* a3 = a2 + kstep; const char* b3 = b2 + kstep;
            if (last && has_next) S.a_ready(nxt);
            if constexpr (SP2) {
            PG8_LDB(B0, 0, 0); PG8_LDB(B1, 0, 1); PG8_SCHED; PG8_LDA(At, 0, 0); PG8_STAGE(PG8_SA(1, 1), a1 + hstep, voffA);
            PG8_WAIT_V(8); PG8_WAIT_L(0); PG8_BAR; PG8_MMA(0, 0, At, B0); PG8_MMA(0, 1, At, B1); PG8_BAR; PG8_SCHED;
            PG8_LDA(At, 0, 1); PG8_STAGE(PG8_SB(0, 0), b2, voffB); PG8_STAGE(PG8_SB(0, 1), b2 + hstep, voffB); PG8_STAGE(PG8_SA(0, 0), a2, voffA);
            PG8_WAIT_V(8); PG8_WAIT_L(0); PG8_BAR; PG8_MMA(1, 0, At, B0); PG8_MMA(1, 1, At, B1); PG8_BAR; PG8_SCHED;
            PG8_LDB(B0, 1, 0); PG8_LDB(B1, 1, 1); PG8_SCHED; PG8_LDA(At, 1, 0); PG8_STAGE(PG8_SA(0, 1), a2 + hstep, voffA);
            PG8_WAIT_V(8); PG8_WAIT_L(0); PG8_BAR; PG8_MMA(0, 0, At, B0); PG8_MMA(0, 1, At, B1); PG8_BAR; PG8_SCHED;
            PG8_LDA(At, 1, 1); PG8_STAGE(PG8_SB(1, 0), b3, voffB); PG8_STAGE(PG8_SB(1, 1), b3 + hstep, voffB); PG8_STAGE(PG8_SA(1, 0), a3, voffA);
            PG8_WAIT_V(8); PG8_WAIT_L(0); PG8_BAR; PG8_MMA(1, 0, At, B0); PG8_MMA(1, 1, At, B1); PG8_BAR; PG8_SCHED;
            } else {
            PG8_LDB(B0, 0, 0); PG8_SCHED; PG8_LDA(At, 0, 0); PG8_STAGE(PG8_SA(1, 1), a1 + hstep, voffA);
            PG8_WAIT_L(8); PG8_BAR; PG8_WAIT_L(0); PG8_MMA(0, 0, At, B0); PG8_BAR; PG8_SCHED;
            PG8_LDB(B1, 0, 1); PG8_STAGE(PG8_SB(0, 0), b2, voffB);
            PG8_BAR; PG8_WAIT_L(0); PG8_MMA(0, 1, At, B1); PG8_BAR;
            PG8_LDA(At, 0, 1); PG8_STAGE(PG8_SA(0, 0), a2, voffA);
            PG8_BAR; PG8_WAIT_L(0); PG8_MMA(1, 0, At, B0); PG8_BAR; PG8_SCHED;
            PG8_STAGE(PG8_SB(0, 1), b2 + hstep, voffB);
            PG8_WAIT_V(6); PG8_BAR; PG8_MMA(1, 1, At, B1); PG8_BAR;
            PG8_LDB(B0, 1, 0); PG8_SCHED; PG8_LDA(At, 1, 0); PG8_STAGE(PG8_SA(0, 1), a2 + hstep, voffA);
            PG8_WAIT_L(8); PG8_BAR; PG8_WAIT_L(0); PG8_MMA(0, 0, At, B0); PG8_BAR; PG8_SCHED;
            PG8_LDB(B1, 1, 1); PG8_STAGE(PG8_SB(1, 0), b3, voffB);
            PG8_BAR; PG8_WAIT_L(0); PG8_MMA(0, 1, At, B1); PG8_BAR;
            PG8_LDA(At, 1, 1); PG8_STAGE(PG8_SA(1, 0), a3, voffA);
            PG8_BAR; PG8_WAIT_L(0); PG8_MMA(1, 0, At, B0); PG8_BAR; PG8_SCHED;
            PG8_STAGE(PG8_SB(1, 1), b3 + hstep, voffB);
            PG8_WAIT_V(6); PG8_BAR; PG8_MMA(1, 1, At, B1); PG8_BAR;
            }
        }
        if constexpr (ALIGN_EPI) { if (wr == 0) PG8_BAR; }
        if constexpr (!Epi::AFTER_DRAIN) { E(acc, cur, wr, wc, fr, fq); S.done(cur); }
        if (!has_next) break;
#pragma unroll
        for (int a = 0; a < 2; ++a)
#pragma unroll
            for (int b = 0; b < 2; ++b)
#pragma unroll
                for (int m = 0; m < 4; ++m)
#pragma unroll
                    for (int n = 0; n < 2; ++n) acc[a][b][m][n] = (f32x4){0.f, 0.f, 0.f, 0.f};
        cur = nxt; cA = nA; cB = nB; ++ui;
        if constexpr (ALIGN_EPI) { if (wr == 1) PG8_BAR; }
    }
    PG8_WAIT_V(0);
    if constexpr (!ALIGN_EPI) { if (wr == 0) PG8_BAR; }
    PG8_BAR;
    if constexpr (Epi::AFTER_DRAIN) { E.fused(acc, cur, wr, wc, fr, fq, lds, wid, lane); S.done(cur); }
#undef PG8_SA
#undef PG8_SB
#undef PG8_STAGE
#undef PG8_LDA
#undef PG8_LDB
#undef PG8_MMA
#undef PG8_WAIT_V
#undef PG8_WAIT_L
#undef PG8_BAR
#undef PG8_SCHED
}
}
#define LAS __attribute__((address_space(3)))
typedef unsigned short bf16;
typedef short s16x4 __attribute__((ext_vector_type(4)));
typedef short bf16x8 __attribute__((ext_vector_type(8)));
typedef float f32x4 __attribute__((ext_vector_type(4)));
typedef float f32x16 __attribute__((ext_vector_type(16)));
typedef unsigned u32x2 __attribute__((ext_vector_type(2)));
typedef unsigned u32x4 __attribute__((ext_vector_type(4)));
constexpr int SEQ = 8192, NTOK = 16384, DM = 2048;
constexpr float LOG2E = 1.4426950408889634f;
__device__ __forceinline__ unsigned cvtpk(float lo, float hi) { unsigned r; asm volatile("v_cvt_pk_bf16_f32 %0, %1, %2" : "=v"(r) : "v"(lo), "v"(hi)); return r; }
__device__ __forceinline__ unsigned offb(unsigned row, unsigned ch) { return 256u * row + 16u * (ch ^ (((row & 3) << 2) | ((row >> 2) & 3))); }
__device__ __forceinline__ int pislot(int rho) { const int a = rho >> 3, h = (rho >> 2) & 1, c = rho & 3; return 16 * (a >> 1) + 8 * h + 4 * (a & 1) + c; }
__device__ __forceinline__ bf16x8 pack8(const f32x16& s, int base) {
    u32x4 w; w.x = cvtpk(s[base + 0], s[base + 1]); w.y = cvtpk(s[base + 2], s[base + 3]); w.z = cvtpk(s[base + 4], s[base + 5]); w.w = cvtpk(s[base + 6], s[base + 7]);
    return __builtin_bit_cast(bf16x8, w); }
__device__ __forceinline__ bf16x8 tr8(LAS unsigned char* p0, LAS unsigned char* p1) {
    const s16x4 a = __builtin_amdgcn_ds_read_tr16_b64_v4i16((LAS s16x4*)p0), b = __builtin_amdgcn_ds_read_tr16_b64_v4i16((LAS s16x4*)p1);
    bf16x8 v; v.s0 = a.x; v.s1 = a.y; v.s2 = a.z; v.s3 = a.w; v.s4 = b.x; v.s5 = b.y; v.s6 = b.z; v.s7 = b.w; return v; }

__device__ __forceinline__ void store_pair16(bf16* p, int hi, u32x2 a  , u32x2 b  ) {
    const auto r0 = __builtin_amdgcn_permlane32_swap(a.x, b.x, false, false); const auto r1 = __builtin_amdgcn_permlane32_swap(a.y, b.y, false, false);
    u32x4 w; w.x = r0[0]; w.y = r1[0]; w.z = r0[1]; w.w = r1[1];
    *(u32x4*)(p + 8 * hi) = w;
}
__device__ __forceinline__ void fox_attn_phase(LAS unsigned char* lds, const bf16* Q, bf16* Oo, const bf16* K, const bf16* V, const float* D2, const float* gq, const float* gk, int G, int c) {
    int tid_ = threadIdx.x; asm volatile("" : "+v"(tid_));
    const int tid = tid_, lane = tid & 63, w = __builtin_amdgcn_readfirstlane(tid >> 6), hi = lane >> 5, l32 = lane & 31;
    float mq = 0.f, mk = 0.f;
    for (int i = 0; i < 128; ++i) { mq = fmaxf(mq, fabsf(gq[i])); mk = fmaxf(mk, fabsf(gk[i])); }
    const float B2 = 1.03f * 11.313708499f * LOG2E * mq * mk, PRUNE = 2.0f * B2 + 40.0f;
    const unsigned krow = (unsigned)pislot(l32), kx = ((krow & 3) << 2) | ((krow >> 2) & 3);
    unsigned kaddr[8];
#pragma unroll
    for (int s = 0; s < 8; ++s) kaddr[s] = 256u * krow + 16u * ((unsigned)(2 * s + hi) ^ kx);
    unsigned vaddr[4][2];
    { const unsigned blk = (lane >> 4) & 1, q4 = (lane & 15) >> 2, p = lane & 3;
#pragma unroll
      for (int cc = 0; cc < 4; ++cc)
#pragma unroll
        for (int t = 0; t < 2; ++t) vaddr[cc][t] = 16384u + offb(8 * hi + 4 * t + q4, 4 * cc + 2 * blk + (p >> 1)) + 8 * (p & 1); }
    const int srow = tid >> 4, sch = tid & 15;
    const unsigned soff0 = offb(srow, sch), soff1 = offb(srow + 32, sch);
    for (int it = 0;; ++it) {
        const int L = it * G + ((it & 1) ? (G - 1 - c) : c); if (L >= 1024) break;
        const int qb = 31 - (L >> 5), bh = L & 31, b = bh >> 4, h = bh & 15;
        const int q0 = 256 * qb, q0w = q0 + 32 * w, jend = 4 * qb + 3, jwl = (q0w + 31) >> 6;
        const size_t tok0 = (size_t)b * SEQ;
        const float* d2 = D2 + (size_t)bh * SEQ;
        const bf16* Qp = Q + (tok0 + q0w + l32) * DM + h * 128 + 8 * hi;
        bf16x8 qf[8];
#pragma unroll
        for (int s = 0; s < 8; ++s) qf[s] = *(const bf16x8*)(Qp + 16 * s);
        const int jstart = 0;
        const bf16* Kg = K + (tok0 + srow) * DM + h * 128 + sch * 8;
        const bf16* Vg = V + (tok0 + srow) * DM + h * 128 + sch * 8;
        u32x4 pk0, pk1, pv0, pv1; float pd = 0.f;
#define FOX_LOAD(J) do { const size_t o_ = (size_t)(64 * (J)) * DM; pk0 = *(const u32x4*)(Kg + o_); pk1 = *(const u32x4*)(Kg + o_ + 32 * DM); pv0 = *(const u32x4*)(Vg + o_); pv1 = *(const u32x4*)(Vg + o_ + 32 * DM); \
        if (tid < 64) pd = d2[64 * (J) + tid]; } while (0)
#define FOX_STORE(BUF) do { LAS unsigned char* b_ = lds + (BUF) * 33024; *(LAS u32x4*)(b_ + soff0) = pk0; *(LAS u32x4*)(b_ + soff1) = pk1; *(LAS u32x4*)(b_ + 16384 + soff0) = pv0; *(LAS u32x4*)(b_ + 16384 + soff1) = pv1; \
        if (tid < 64) *(LAS float*)(b_ + 32768 + 4 * tid) = pd; } while (0)
        FOX_LOAD(jend);
        f32x16 O[4];
#pragma unroll
        for (int cc = 0; cc < 4; ++cc)
#pragma unroll
            for (int r = 0; r < 16; ++r) O[cc][r] = 0.f;
        float lrun = 0.f;
        const int qpos = q0w + l32;
        const float d2q = d2[qpos], mfix = d2q + B2;
        LAS float* red = (LAS float*)(lds + 2 * 33024);
        __syncthreads();
        FOX_STORE(jend & 1);
        if (jstart < jend) FOX_LOAD(jend - 1);
        __syncthreads();
        for (int j = jend; j >= jstart; --j) {
            if (j > jstart) FOX_STORE((j - 1) & 1);
            if (j - 1 > jstart) FOX_LOAD(j - 2);
            LAS unsigned char* tb = lds + (j & 1) * 33024;
            const float bound = d2[64 * (j > 0 ? j : 1) - 1] + __builtin_amdgcn_logf((float)(64 * (j > 0 ? j : 1))) + 24.0f;
            if (j <= jwl) {
                f32x16 S0, S1;
                { const LAS float* dl = (const LAS float*)(tb + 32768) + 8 * hi;
                  const f32x4 a0 = *(const LAS f32x4*)(dl), a1 = *(const LAS f32x4*)(dl + 4), a2 = *(const LAS f32x4*)(dl + 16), a3 = *(const LAS f32x4*)(dl + 20);
                  const f32x4 b0 = *(const LAS f32x4*)(dl + 32), b1 = *(const LAS f32x4*)(dl + 36), b2 = *(const LAS f32x4*)(dl + 48), b3 = *(const LAS f32x4*)(dl + 52);
#pragma unroll
                  for (int e = 0; e < 4; ++e) { S0[e] = a0[e]; S0[4 + e] = a1[e]; S0[8 + e] = a2[e]; S0[12 + e] = a3[e]; S1[e] = b0[e]; S1[4 + e] = b1[e]; S1[8 + e] = b2[e]; S1[12 + e] = b3[e]; } }
#pragma unroll
                for (int hb = 0; hb < 2; ++hb) {
                    bf16x8 ka[4], kc[4];
#pragma unroll
                    for (int s = 0; s < 4; ++s) { ka[s] = *(const LAS bf16x8*)(tb + kaddr[4 * hb + s]); kc[s] = *(const LAS bf16x8*)(tb + kaddr[4 * hb + s] + 8192); }
                    __builtin_amdgcn_sched_barrier(0);
#pragma unroll
                    for (int s = 0; s < 4; ++s) { S0 = __builtin_amdgcn_mfma_f32_32x32x16_bf16(ka[s], qf[4 * hb + s], S0, 0, 0, 0); S1 = __builtin_amdgcn_mfma_f32_32x32x16_bf16(kc[s], qf[4 * hb + s], S1, 0, 0, 0); }
                    __builtin_amdgcn_sched_barrier(0);
                }
                if (64 * j + 63 > q0w) {
                    const int kb = 64 * j + 8 * hi;
#pragma unroll
                    for (int r = 0; r < 16; ++r) { const int key = kb + 16 * (r >> 3) + (r & 7); if (key > qpos) S0[r] = -INFINITY; if (key + 32 > qpos) S1[r] = -INFINITY; }
                }
                float ps = 0.f;
#pragma unroll
                for (int r = 0; r < 16; ++r) { S0[r] = __builtin_amdgcn_exp2f(S0[r] - mfix); S1[r] = __builtin_amdgcn_exp2f(S1[r] - mfix); ps += S0[r] + S1[r]; }
                lrun += ps;
                bf16x8 P[4]; P[0] = pack8(S0, 0); P[1] = pack8(S0, 8); P[2] = pack8(S1, 0); P[3] = pack8(S1, 8);
                { bf16x8 va[4], vb[4];
#pragma unroll
                  for (int cc = 0; cc < 4; ++cc) va[cc] = tr8(tb + vaddr[cc][0], tb + vaddr[cc][1]);
#pragma unroll
                  for (int ks = 0; ks < 4; ++ks) {
                      if (ks < 3) {
#pragma unroll
                          for (int cc = 0; cc < 4; ++cc) { const bf16x8 t = tr8(tb + vaddr[cc][0] + 4096 * (ks + 1), tb + vaddr[cc][1] + 4096 * (ks + 1)); if (ks & 1) va[cc] = t; else vb[cc] = t; } }
                      __builtin_amdgcn_sched_barrier(0);
#pragma unroll
                      for (int cc = 0; cc < 4; ++cc) O[cc] = __builtin_amdgcn_mfma_f32_32x32x16_bf16((ks & 1) ? vb[cc] : va[cc], P[ks], O[cc], 0, 0, 0);
                      __builtin_amdgcn_sched_barrier(0);
                  } }
            }
            { float met = __builtin_amdgcn_logf(lrun + __shfl_xor(lrun, 32)) + d2q;
#pragma unroll
              for (int o = 1; o < 32; o <<= 1) met = fminf(met, __shfl_xor(met, o));
              if (lane == 0) red[(j & 1) * 8 + w] = met; }
            __syncthreads();
            if (j > jstart) {
                const f32x4 ra = *(const LAS f32x4*)(red + (j & 1) * 8), rb = *(const LAS f32x4*)(red + (j & 1) * 8 + 4);
                const float mall = fminf(fminf(fminf(ra[0], ra[1]), fminf(ra[2], ra[3])), fminf(fminf(rb[0], rb[1]), fminf(rb[2], rb[3])));
                if (bound <= mall) break;
            }
        }
#undef FOX_LOAD
#undef FOX_STORE
        lrun += __shfl_xor(lrun, 32);
        const float inv = 1.0f / lrun;
        bf16* Op = Oo + (tok0 + q0w + l32) * DM + h * 128;
#pragma unroll
        for (int cc = 0; cc < 4; ++cc)
#pragma unroll
            for (int g = 0; g < 4; g += 2) { u32x2 wa, wb;
                wa.x = cvtpk(O[cc][4 * g] * inv, O[cc][4 * g + 1] * inv); wa.y = cvtpk(O[cc][4 * g + 2] * inv, O[cc][4 * g + 3] * inv);
                wb.x = cvtpk(O[cc][4 * g + 4] * inv, O[cc][4 * g + 5] * inv); wb.y = cvtpk(O[cc][4 * g + 6] * inv, O[cc][4 * g + 7] * inv);
                store_pair16(Op + 32 * cc + 8 * g, hi, wa, wb); }
    }
    __syncthreads();
}
__device__ __forceinline__ void lds_k4(bf16x8 (&k)[4], unsigned a0, unsigned a1, unsigned a2, unsigned a3) {
    asm volatile("ds_read_b128 %0, %4\n\tds_read_b128 %1, %5\n\tds_read_b128 %2, %6\n\tds_read_b128 %3, %7\n\ts_waitcnt lgkmcnt(0)"
                 : "=&v"(k[0]), "=&v"(k[1]), "=&v"(k[2]), "=&v"(k[3]) : "v"(a0), "v"(a1), "v"(a2), "v"(a3) : "memory");
}
template <int OFF> __device__ __forceinline__ void lds_v4(bf16x8 (&v)[4], unsigned a0, unsigned a1, unsigned b0, unsigned b1) {
    s16x4 r0, r1, r2, r3, r4, r5, r6, r7;
    asm volatile("ds_read_b64_tr_b16 %0, %8 offset:%12\n\tds_read_b64_tr_b16 %1, %9 offset:%12\n\tds_read_b64_tr_b16 %2, %8 offset:%13\n\tds_read_b64_tr_b16 %3, %9 offset:%13\n\t"
                 "ds_read_b64_tr_b16 %4, %10 offset:%12\n\tds_read_b64_tr_b16 %5, %11 offset:%12\n\tds_read_b64_tr_b16 %6, %10 offset:%13\n\tds_read_b64_tr_b16 %7, %11 offset:%13\n\ts_waitcnt lgkmcnt(0)"
                 : "=&v"(r0), "=&v"(r1), "=&v"(r2), "=&v"(r3), "=&v"(r4), "=&v"(r5), "=&v"(r6), "=&v"(r7) : "v"(a0), "v"(a1), "v"(b0), "v"(b1), "i"(OFF), "i"(OFF + 4096) : "memory");
    v[0] = __builtin_shufflevector(r0, r1, 0, 1, 2, 3, 4, 5, 6, 7); v[1] = __builtin_shufflevector(r2, r3, 0, 1, 2, 3, 4, 5, 6, 7);
    v[2] = __builtin_shufflevector(r4, r5, 0, 1, 2, 3, 4, 5, 6, 7); v[3] = __builtin_shufflevector(r6, r7, 0, 1, 2, 3, 4, 5, 6, 7);
}
__device__ __forceinline__ void dil_pv_asm(f32x16 (&Oa)[8], unsigned vt, unsigned va0, unsigned va1, const bf16x8 (&P)[2]) {
    bf16x8 v[4];
#define DIL_PV4(C0, OFF, X0, X1) do { lds_v4<OFF>(v, vt + (va0 ^ (X0)), vt + (va1 ^ (X0)), vt + (va0 ^ (X1)), vt + (va1 ^ (X1))); \
        Oa[C0] = __builtin_amdgcn_mfma_f32_32x32x16_bf16(v[0], P[0], Oa[C0], 0, 0, 0); Oa[C0 + 1] = __builtin_amdgcn_mfma_f32_32x32x16_bf16(v[2], P[0], Oa[C0 + 1], 0, 0, 0); \
        Oa[C0] = __builtin_amdgcn_mfma_f32_32x32x16_bf16(v[1], P[1], Oa[C0], 0, 0, 0); Oa[C0 + 1] = __builtin_amdgcn_mfma_f32_32x32x16_bf16(v[3], P[1], Oa[C0 + 1], 0, 0, 0); \
        asm volatile("" : "+v"(va0), "+v"(va1)); } while (0)
    DIL_PV4(0, 0, 0u, 64u); DIL_PV4(2, 0, 128u, 192u); DIL_PV4(4, 8192, 0u, 64u); DIL_PV4(6, 8192, 128u, 192u);
#undef DIL_PV4
}
template <int RG> __device__ __forceinline__ void dil_cinit(f32x16& S, int kb0, int tq, int hi, float slope2, float mfix) {
    const float base = -slope2 * (float)(tq - kb0 - RG * 8 * hi) - mfix;
#pragma unroll
    for (int r = 0; r < 16; ++r) S[r] = __builtin_fmaf(slope2, (float)(RG * (16 * (r >> 3) + (r & 7))), base);
}
template <int RG> __device__ __forceinline__ void dil_softmax(f32x16& S, int kb0, int tq, int hi, float& lrun, bf16x8 (&P)[2]) {
    const int d0 = tq - kb0 - RG * 8 * hi; const unsigned lim = (unsigned)(tq < 128 * RG ? tq : 128 * RG);
    float ps = 0.f;
#pragma unroll
    for (int r = 0; r < 16; ++r) { const unsigned dist = (unsigned)(d0 - RG * (16 * (r >> 3) + (r & 7)));
        const float e = __builtin_amdgcn_exp2f(S[r]); S[r] = (dist <= lim) ? e : 0.f; ps += S[r]; }
    lrun += ps; P[0] = pack8(S, 0); P[1] = pack8(S, 8);
}
__device__ __forceinline__ void dil_pv(f32x16 (&Oa)[8], LAS unsigned char* vt, unsigned va0, unsigned va1, const bf16x8 (&P)[2]) {
    asm volatile("" : "+v"(va0), "+v"(va1));
#pragma unroll
    for (int cc = 0; cc < 8; ++cc)
#pragma unroll
        for (int ks = 0; ks < 2; ++ks) { LAS unsigned char* vb = vt + (cc >> 2) * 8192 + 4096 * ks;
            const bf16x8 vf = tr8(vb + (va0 ^ ((cc & 3) << 6)), vb + (va1 ^ ((cc & 3) << 6)));
            Oa[cc] = __builtin_amdgcn_mfma_f32_32x32x16_bf16(vf, P[ks], Oa[cc], 0, 0, 0); }
}
template <int RG, int NBLK, int NSTREAM, int BPS  >
__device__ __forceinline__ void dil_shared_group(LAS unsigned char* lds_all, f32x16 (&Oa)[8], float& lrun, const bf16* Qp, const bf16* Kg  , const bf16* Vg  ,
                                                 int tokb0  , int tq, int w, int lane, int hi, const unsigned kbase, const unsigned kx, const unsigned va0, const unsigned va1, float slope2, float mfix) {
    constexpr int NW = 8 / NSTREAM, NSLOT = 24 / NW, NSTEP = NBLK / BPS, BUFB = BPS * 24576;
    static_assert(NBLK % BPS == 0, "blocks per step");
    const int stream = (NSTREAM == 1) ? 0 : (w >> 2), wi = w & (NW - 1);
    LAS unsigned char* sb = lds_all + stream * (2 * BUFB);
    const int drow = lane >> 4, dchp = lane & 15;
    bf16x8 qf[8];
#pragma unroll
    for (int s = 0; s < 8; ++s) qf[s] = *(const bf16x8*)(Qp + 16 * s);
#define DIL_TDMA(M, BUF) do { _Pragma("unroll") for (int bb_ = 0; bb_ < BPS; ++bb_) { const int tb_ = tokb0 + RG * 32 * ((M) * BPS + bb_); _Pragma("unroll") for (int q_ = 0; q_ < NSLOT; ++q_) { const int slot_ = wi + NW * q_; \
        const int row_ = 4 * (slot_ & 7) + drow; const int tk_ = tb_ + RG * row_; const int ch_ = dchp ^ (((row_ & 3) << 2) | ((row_ >> 2) & 3)); \
        const bf16* src_ = (slot_ < 8) ? (Kg + (long)tk_ * 3072 + ch_ * 8) : (Vg + (long)tk_ * DM + ((slot_ - 8) >> 3) * 128 + ch_ * 8); \
        __builtin_amdgcn_global_load_lds((const unsigned*)src_, (LAS unsigned*)(sb + (BUF) * BUFB + bb_ * 24576 + slot_ * 1024), 16, 0, 0); } } } while (0)
    DIL_TDMA(0, 0);
    asm volatile("s_waitcnt vmcnt(0)" ::: "memory");
    __syncthreads();
#pragma unroll 1
    for (int m = 0; m < NSTEP; ++m) {
        if (m + 1 < NSTEP) DIL_TDMA(m + 1, (m + 1) & 1);
#pragma unroll
        for (int bb = 0; bb < BPS; ++bb) {
            LAS unsigned char* tb = sb + (m & 1) * BUFB + bb * 24576;
            const int kb0 = tokb0 + RG * 32 * (m * BPS + bb);
            if (kb0 + RG * 31 >= 0) {
                f32x16 S;
                dil_cinit<RG>(S, kb0, tq, hi, slope2, mfix);
                const unsigned tba = (unsigned)(size_t)tb + kbase;
#pragma unroll
                for (int hb = 0; hb < 2; ++hb) { bf16x8 kf[4];
                    lds_k4(kf, tba + 16u * ((unsigned)(8 * hb + 0 + hi) ^ kx), tba + 16u * ((unsigned)(8 * hb + 2 + hi) ^ kx), tba + 16u * ((unsigned)(8 * hb + 4 + hi) ^ kx), tba + 16u * ((unsigned)(8 * hb + 6 + hi) ^ kx));
#pragma unroll
                    for (int s = 0; s < 4; ++s) S = __builtin_amdgcn_mfma_f32_32x32x16_bf16(kf[s], qf[4 * hb + s], S, 0, 0, 0); }
                bf16x8 P[2];
                dil_softmax<RG>(S, kb0, tq, hi, lrun, P);
                dil_pv_asm(Oa, (unsigned)(size_t)tb + 8192u, va0, va1, P);
            }
        }
        asm volatile("s_waitcnt vmcnt(0)" ::: "memory");
        __syncthreads();
    }
#undef DIL_TDMA
}
__device__ __forceinline__ void dil_attn_phase(LAS unsigned char* lds_all, const bf16* Qd, const bf16* Kd, const bf16* Vd, bf16* O, const float* gq, const float* gk, int G, int c) {
    float mfix = 0.f;
    for (int g = 0; g < 3; ++g) { float mq = 0.f, mk = 0.f;
        for (int i = 0; i < 128; ++i) { mq = fmaxf(mq, fabsf(gq[g * 128 + i])); mk = fmaxf(mk, fabsf(gk[g * 128 + i])); }
        mfix = fmaxf(mfix, 1.03f * 11.313708499f * LOG2E * mq * mk); }
    mfix = __builtin_bit_cast(float, __builtin_amdgcn_readfirstlane(__builtin_bit_cast(int, mfix)));
    for (int it = 0;; ++it) {
        const int vc = (G % 8 == 0) ? (c % 8) * (G / 8) + c / 8 : c;
        const int u = it * G + vc; if (u >= 512) break;
        int tid_ = threadIdx.x; asm volatile("" : "+v"(tid_));
        const int tid = tid_, lane = tid & 63, w = __builtin_amdgcn_readfirstlane(tid >> 6), hi = lane >> 5, l32 = lane & 31;
        LAS unsigned char* ldsw = lds_all + w * 16384;
        unsigned va0, va1;
        { const unsigned blk = (lane >> 4) & 1, q4 = (lane & 15) >> 2, p = lane & 3;
          va0 = offb(8 * hi + q4, 2 * blk + (p >> 1)) + 8 * (p & 1); va1 = offb(8 * hi + 4 + q4, 2 * blk + (p >> 1)) + 8 * (p & 1); }
        const int kslot = pislot(l32);
        const unsigned kx = ((kslot & 3) << 2) | ((kslot >> 2) & 3), kbase = 256u * kslot;
        const int half = u & 1, ab = (u >> 1) & 15, bh = u >> 5, b = bh >> 3, h = bh & 7;
        const int cl = 2 * half + (w >> 2), rho = 4 * (w & 3) + cl;
        const size_t tok0 = (size_t)b * SEQ;
        const int tq0 = 512 * ab + rho, tq = tq0 + 16 * l32;
        const bf16* Vg = Vd + tok0 * DM + h * 256;
        f32x16 Oa[8];
#pragma unroll
        for (int cc = 0; cc < 8; ++cc)
#pragma unroll
            for (int r = 0; r < 16; ++r) Oa[cc][r] = 0.f;
        float lrun = 0.f;
        __syncthreads();
        {
            const float slope2 = __builtin_bit_cast(float, __builtin_amdgcn_readfirstlane(__builtin_bit_cast(int, __builtin_amdgcn_exp2f((float)(h + 1) * (-8.0f / 24.0f)) * LOG2E)));
            dil_shared_group<1, 20, 1, 2>(lds_all, Oa, lrun, Qd + (tok0 + tq) * 3072 + h * 128 + 8 * hi, Kd + tok0 * 3072 + h * 128, Vg, 32 * (16 * ab - 4), tq, w, lane, hi, kbase, kx, va0, va1, slope2, mfix);
        }
        {
            const float slope2 = __builtin_bit_cast(float, __builtin_amdgcn_readfirstlane(__builtin_bit_cast(int, __builtin_amdgcn_exp2f((float)(8 + h + 1) * (-8.0f / 24.0f)) * LOG2E)));
            dil_shared_group<4, 8, 2, 1>(lds_all, Oa, lrun, Qd + (tok0 + tq) * 3072 + (8 + h) * 128 + 8 * hi, Kd + tok0 * 3072 + (8 + h) * 128, Vg, 4 * 32 * (4 * ab - 4) + cl, tq, w, lane, hi, kbase, kx, va0, va1, slope2, mfix);
        }
        {
            constexpr int rg = 16;
            int t3 = threadIdx.x; asm volatile("" : "+v"(t3));
            const int lane3 = t3 & 63, hi = lane3 >> 5, l32 = lane3 & 31, kslot = pislot(l32), tq = tq0 + 16 * l32, drow = lane3 >> 4, dchp = lane3 & 15;
            unsigned va0, va1;
            { const unsigned blk = (lane3 >> 4) & 1, q4 = (lane3 & 15) >> 2, p = lane3 & 3;
              va0 = offb(8 * hi + q4, 2 * blk + (p >> 1)) + 8 * (p & 1); va1 = offb(8 * hi + 4 + q4, 2 * blk + (p >> 1)) + 8 * (p & 1); }
            const float slope2 = __builtin_bit_cast(float, __builtin_amdgcn_readfirstlane(__builtin_bit_cast(int, __builtin_amdgcn_exp2f((float)(16 + h + 1) * (-8.0f / 24.0f)) * LOG2E)));
            const bf16* Qp = Qd + (tok0 + tq) * 3072 + (16 + h) * 128 + 8 * hi;
            const bf16* Kg = Kd + tok0 * 3072 + (16 + h) * 128 + 8 * hi;
            const int tlo = tq0 - 128 * rg;
            bf16x8 qf[8];
#pragma unroll
            for (int s = 0; s < 8; ++s) qf[s] = *(const bf16x8*)(Qp + 16 * s);
#define DIL_VDMA(KB0) do { _Pragma("unroll") for (int i_ = 0; i_ < 16; ++i_) { const int row_ = 4 * (i_ & 7) + drow; const int tk_ = (KB0) + rg * row_; \
        const int ch_ = dchp ^ (((row_ & 3) << 2) | ((row_ >> 2) & 3)); \
        __builtin_amdgcn_global_load_lds((const unsigned*)(Vg + (long)tk_ * DM + (i_ >> 3) * 128 + ch_ * 8), (LAS unsigned*)(ldsw + i_ * 1024), 16, 0, 0); } } while (0)
#define DIL_KLOAD(KB0) do { const int tkk_ = (KB0) + rg * kslot; const bf16* Kp_ = Kg + (long)tkk_ * 3072; \
        _Pragma("unroll") for (int s_ = 0; s_ < 8; ++s_) kf[s_] = *(const bf16x8*)(Kp_ + 16 * s_); } while (0)
            int kb = 0;
            while (tlo + rg * (32 * kb + 31) < 0) ++kb;
#pragma unroll 1
            for (; kb < 5; ++kb) {
                const int kb0 = tlo + rg * 32 * kb;
                DIL_VDMA(kb0);
                f32x16 S;
                dil_cinit<rg>(S, kb0, tq, hi, slope2, mfix);
                { const bf16* Kp = Kg + (long)(kb0 + rg * kslot) * 3072;
                  bf16x8 kf[8];
#pragma unroll
                  for (int s = 0; s < 8; ++s) kf[s] = *(const bf16x8*)(Kp + 16 * s);
                  asm volatile("" ::: "memory");
#pragma unroll
                  for (int s = 0; s < 8; ++s) S = __builtin_amdgcn_mfma_f32_32x32x16_bf16(kf[s], qf[s], S, 0, 0, 0);
                  asm volatile("" ::: "memory"); }
                bf16x8 P[2];
                dil_softmax<rg>(S, kb0, tq, hi, lrun, P);
                asm volatile("s_waitcnt vmcnt(0)" ::: "memory");
                dil_pv(Oa, ldsw, va0, va1, P);
                asm volatile("s_waitcnt lgkmcnt(0)" ::: "memory");
            }
#undef DIL_VDMA
#undef DIL_KLOAD
        }
        lrun += __shfl_xor(lrun, 32);
        const float inv = 1.0f / lrun;
        int t2 = threadIdx.x; asm volatile("" : "+v"(t2));
        bf16* Op = O + (tok0 + tq0 + 16 * (t2 & 31)) * DM + h * 256;
        const int hi2 = (t2 >> 5) & 1;
#pragma unroll
        for (int cc = 0; cc < 8; ++cc)
#pragma unroll
            for (int gg = 0; gg < 4; gg += 2) { u32x2 wa, wb;
                wa.x = cvtpk(Oa[cc][4 * gg] * inv, Oa[cc][4 * gg + 1] * inv); wa.y = cvtpk(Oa[cc][4 * gg + 2] * inv, Oa[cc][4 * gg + 3] * inv);
                wb.x = cvtpk(Oa[cc][4 * gg + 4] * inv, Oa[cc][4 * gg + 5] * inv); wb.y = cvtpk(Oa[cc][4 * gg + 6] * inv, Oa[cc][4 * gg + 7] * inv);
                store_pair16(Op + 32 * cc + 8 * gg, hi2, wa, wb); }
    }
    __syncthreads();
}
#define XB_TMO      128
#define XB_XCNT(j)  (256  + 64 * (j))
#define XB_XSUB(j)  (1280 + 64 * (j))
#define XB_XGEN(j)  (2304 + 64 * (j))
#define XB_TOP      3328
#define XB_TOPGEN   3392
#define XCD_BAR_WORDS 3456
#define XB_SPIN_CAP (1u << 18)

__device__ __forceinline__ unsigned xb_ld(unsigned* p)              { return __hip_atomic_load(p, __ATOMIC_RELAXED, __HIP_MEMORY_SCOPE_AGENT); }
__device__ __forceinline__ unsigned xb_add(unsigned* p, unsigned v) { return __hip_atomic_fetch_add(p, v, __ATOMIC_RELAXED, __HIP_MEMORY_SCOPE_AGENT); }
__device__ __forceinline__ unsigned xb_xcc_id() { return (unsigned)__builtin_amdgcn_s_getreg((3 << 11) | 20) & 0xFu; }
#define XB_SPIN(cond, bar) do { unsigned _sp = 0; while (cond) { __builtin_amdgcn_s_sleep(1); \
    if ((++_sp & 255u) == 0u) { if (xb_ld(&(bar)[XB_TMO])) break; if (_sp > XB_SPIN_CAP) { atomicAdd(&(bar)[XB_TMO], 1u); break; } } } } while (0)

struct XcdBarrier {
    unsigned* bar; unsigned x;
    volatile LAS unsigned* st;
};

__device__ __forceinline__ XcdBarrier xcd_barrier_post(unsigned* bar, volatile LAS unsigned* st) {
    XcdBarrier b; b.bar = bar; b.x = xb_xcc_id(); b.st = st;
    if (threadIdx.x == 0) (void)xb_add(&bar[XB_XCNT(b.x)], 1u);
    return b;
}
__device__ __forceinline__ void xcd_barrier_complete(unsigned* bar, unsigned x, unsigned& nloc, unsigned& nx) {
    const unsigned G = gridDim.x * gridDim.y * gridDim.z;
    unsigned sum, cnt, mine, sp = 0u;
    for (;;) {
        sum = 0u; cnt = 0u; mine = 0u;
#pragma unroll
        for (unsigned j = 0; j < 16; ++j) { const unsigned c = xb_ld(&bar[XB_XCNT(j)]); sum += c; cnt += (c > 0u) ? 1u : 0u; mine = (j == x) ? c : mine; }
        if (sum == G) break;
        __builtin_amdgcn_s_sleep(1);
        if ((++sp & 255u) == 0u) { if (xb_ld(&bar[XB_TMO])) break; if (sp > XB_SPIN_CAP) { atomicAdd(&bar[XB_TMO], 1u); break; } }
    }
    nloc = mine > 0u ? mine : 1u; nx = cnt > 0u ? cnt : 1u;
}

__device__ __forceinline__ void xcd_barrier(const XcdBarrier& b) {
    asm volatile("s_waitcnt vmcnt(0)" ::: "memory");
    __syncthreads();
    if (threadIdx.x == 0) {
        unsigned* bar = b.bar;
        __builtin_amdgcn_s_waitcnt(0);
        unsigned nloc = b.st[0], nx = b.st[1];
        if (nloc == 0u) { xcd_barrier_complete(bar, b.x, nloc, nx); b.st[0] = nloc; b.st[1] = nx; }
        const unsigned old = xb_add(&bar[XB_XSUB(b.x)], 1u);
        const unsigned gen = old / nloc;
        if (old + 1u == (gen + 1u) * nloc) {
            __builtin_amdgcn_fence(__ATOMIC_RELEASE, "agent");
            asm volatile("s_waitcnt vmcnt(0)" ::: "memory");
            const unsigned og = xb_add(&bar[XB_TOP], 1u);
            const unsigned tg = og / nx;
            if (og + 1u == (tg + 1u) * nx) xb_add(&bar[XB_TOPGEN], 1u);
            else XB_SPIN(xb_ld(&bar[XB_TOPGEN]) == tg, bar);
            __builtin_amdgcn_fence(__ATOMIC_ACQUIRE, "agent");
            xb_add(&bar[XB_XGEN(b.x)], 1u);
            asm volatile("s_waitcnt vmcnt(0)" ::: "memory");
        } else {
            XB_SPIN(xb_ld(&bar[XB_XGEN(b.x)]) == gen, bar);
            __builtin_amdgcn_fence(__ATOMIC_ACQUIRE, "agent");
            asm volatile("s_waitcnt vmcnt(0)" ::: "memory");
        }
    }
    __syncthreads();
}
constexpr size_t MiB = 1u << 20;
constexpr size_t WS_BAR = 768 * 1024;
constexpr size_t WS_SSP = 0, WS_LF = 1 * MiB, WS_D2 = 2 * MiB, WS_WF = 3 * MiB;
constexpr size_t WS_FOX_IN = 4 * MiB, WS_FOX_O = 28 * MiB, WS_DIL_IN = 36 * MiB, WS_DIL_O = 68 * MiB, WS_UP0 = 76 * MiB, WS_UP1 = 108 * MiB, WS_DN0 = 140 * MiB, WS_DN1 = 172 * MiB;
constexpr size_t WS_XB = 204 * MiB, WS_R = 268 * MiB, WS_END = 524 * MiB;
constexpr int RING_BYTES = 131072, EX_OFF = RING_BYTES, LDS_BYTES = 147456;
constexpr int NWAVES = 8;
#define REP_P0 1
#define REP_FOX 1
#define REP_DIL 1
#define LDS_WAIT() asm volatile("s_waitcnt lgkmcnt(0)" ::: "memory")
__device__ __forceinline__ unsigned f2bf(float f) { unsigned u = __builtin_bit_cast(unsigned, f); return (u + 0x7fffu + ((u >> 16) & 1u)) >> 16; }
__device__ __forceinline__ unsigned pk2(float lo, float hi) { return f2bf(lo) | (f2bf(hi) << 16); }
__device__ __forceinline__ float wave_sum(float v) {
#pragma unroll
    for (int o = 1; o < 64; o <<= 1) v += __shfl_xor(v, o);
    return v;
}
__device__ __forceinline__ void tr_load(f32x4 (&v)[16], const float* W, int ld, int col0, int ncv, int item, int nblk, int lane) {
    const int kb = item / nblk, nb = item % nblk, k0 = 64 * kb, n0 = 64 * nb; const int n4 = (lane & 15) * 4; const bool okc = (n0 + n4) < ncv;
#pragma unroll
    for (int i = 0; i < 16; ++i) { const int kk = 4 * i + (lane >> 4); v[i] = okc ? *(const f32x4*)(W + (size_t)(k0 + kk) * ld + col0 + n0 + n4) : (f32x4){0.f, 0.f, 0.f, 0.f}; }
}
__device__ __forceinline__ void tr_store(const f32x4 (&v)[16], int ncv, int K, const float* g, bf16* WT, LAS float* scr, int item, int nblk, int lane) {
    const int kb = item / nblk, nb = item % nblk, k0 = 64 * kb, n0 = 64 * nb; const int n4 = (lane & 15) * 4;
#pragma unroll
    for (int i = 0; i < 16; ++i) { const int kk = 4 * i + (lane >> 4); f32x4 t = v[i]; if (g) t = t * g[k0 + kk]; LAS float* d = scr + kk * 65 + n4; d[0] = t[0]; d[1] = t[1]; d[2] = t[2]; d[3] = t[3]; }
    LDS_WAIT(); asm volatile("" ::: "memory");
    const int cch = lane & 7;
#pragma unroll
    for (int j = 0; j < 8; ++j) { const int n = (lane >> 3) + 8 * j; const LAS float* s = scr + (8 * cch) * 65 + n;
        u32x4 o; o.x = pk2(s[0 * 65], s[1 * 65]); o.y = pk2(s[2 * 65], s[3 * 65]); o.z = pk2(s[4 * 65], s[5 * 65]); o.w = pk2(s[6 * 65], s[7 * 65]);
        if (n0 + n < ncv) *(u32x4*)(WT + (size_t)(n0 + n) * K + k0 + 8 * cch) = o; }
    LDS_WAIT(); asm volatile("" ::: "memory");
}
struct Args { const float* in[14]; float* out; unsigned char* ws; };
struct Mat { const float* W; int ld, col0, ncv, K; const float* g; size_t wt; };

__global__ void __launch_bounds__(NWAVES * 64, 2) fwd_megakernel(Args args) {
    extern __shared__ __attribute__((aligned(16))) unsigned char lds_raw[];
    LAS unsigned char* lds = (LAS unsigned char*)lds_raw;
    cg::grid_group grid = cg::this_grid();
    const int tid = threadIdx.x, lane = tid & 63, wave = __builtin_amdgcn_readfirstlane(tid >> 6);
    const int G = gridDim.x, c = blockIdx.x;
    unsigned char* ws = args.ws;
    volatile LAS unsigned* bst = (volatile LAS unsigned*)(lds + LDS_BYTES - 64);
    if (tid < 16) bst[tid] = 0u;
    __syncthreads();
    (void)xcd_barrier_post((unsigned*)(ws + WS_BAR), bst);
#define GRID_BAR() do { XcdBarrier b_; b_.bar = (unsigned*)(args.ws + WS_BAR); b_.x = xb_xcc_id(); b_.st = (volatile LAS unsigned*)(lds + LDS_BYTES - 64); xcd_barrier(b_); } while (0)
    const float* x = args.in[0];
    float* out = args.out;
    float* SSP = (float*)(ws + WS_SSP); float* LF = (float*)(ws + WS_LF); float* D2 = (float*)(ws + WS_D2); bf16* WfT = (bf16*)(ws + WS_WF);
    bf16* XB = (bf16*)(ws + WS_XB);
    const int gw = c * NWAVES + wave, NGW = G * NWAVES;

#pragma unroll 1
    for (int rep0 = 0; rep0 < REP_P0; ++rep0)
    {
        LAS float* scr = (LAS float*)(lds + wave * 16640);
        const float* mixg = args.in[10]; const float* mlpg = args.in[11];
#pragma unroll 1
        for (int mi = 0; mi < 9; ++mi) {
            Mat M;
            switch (mi) {
                case 0: M = Mat{args.in[1], 6160, 0, 6144, 2048, mixg, WS_FOX_IN}; break;
                case 1: M = Mat{args.in[1], 6160, 6144, 16, 2048, mixg, WS_WF}; break;
                case 2: M = Mat{args.in[5], 2048, 0, 2048, 2048, nullptr, WS_FOX_O}; break;
                case 3: M = Mat{args.in[6], 8192, 0, 8192, 2048, mixg + 2048, WS_DIL_IN}; break;
                case 4: M = Mat{args.in[9], 2048, 0, 2048, 2048, nullptr, WS_DIL_O}; break;
                case 5: M = Mat{args.in[12], 8192, 0, 8192, 2048, mlpg, WS_UP0}; break;
                case 6: M = Mat{args.in[12] + (size_t)2048 * 8192, 8192, 0, 8192, 2048, mlpg + 2048, WS_UP1}; break;
                case 7: M = Mat{args.in[13], 2048, 0, 2048, 8192, nullptr, WS_DN0}; break;
                default: M = Mat{args.in[13] + (size_t)8192 * 2048, 2048, 0, 2048, 8192, nullptr, WS_DN1}; break;
            }
            const int nblk = (M.ncv + 63) / 64, nitems = (M.K / 64) * nblk;
            if (gw < nitems) {
                f32x4 va[16], vb[16];
                tr_load(va, M.W, M.ld, M.col0, M.ncv, gw, nblk, lane);
                for (int itx = gw; itx < nitems; itx += 2 * NGW) {
                    if (itx + NGW < nitems) tr_load(vb, M.W, M.ld, M.col0, M.ncv, itx + NGW, nblk, lane);
                    tr_store(va, M.ncv, M.K, M.g, (bf16*)(ws + M.wt), scr, itx, nblk, lane);
                    if (itx + NGW < nitems) {
                        if (itx + 2 * NGW < nitems) tr_load(va, M.W, M.ld, M.col0, M.ncv, itx + 2 * NGW, nblk, lane);
                        tr_store(vb, M.ncv, M.K, M.g, (bf16*)(ws + M.wt), scr, itx + NGW, nblk, lane);
                    }
                }
            }
        }
        {
            f32x4 v[8], vn[8];
#pragma unroll
            for (int j = 0; j < 8; ++j) v[j] = ((const f32x4*)(x + (size_t)gw * DM) + lane)[64 * j];
            for (int m = gw; m < NTOK; m += NGW) {
                if (m + NGW < NTOK) {
#pragma unroll
                    for (int j = 0; j < 8; ++j) vn[j] = ((const f32x4*)(x + (size_t)(m + NGW) * DM) + lane)[64 * j]; }
                float s = 0.f;
#pragma unroll
                for (int j = 0; j < 8; ++j) s += (v[j][0] * v[j][0] + v[j][1] * v[j][1]) + (v[j][2] * v[j][2] + v[j][3] * v[j][3]);
                s = wave_sum(s);
                if (lane < 8) SSP[(size_t)lane * NTOK + m] = lane == 0 ? s : 0.f;
                u32x2* o8 = (u32x2*)(XB + (size_t)m * DM) + lane;
#pragma unroll
                for (int j = 0; j < 8; ++j) { u32x2 wv; wv.x = pk2(v[j][0], v[j][1]); wv.y = pk2(v[j][2], v[j][3]); o8[64 * j] = wv; }
#pragma unroll
                for (int j = 0; j < 8; ++j) v[j] = vn[j];
            }
        }
    }
    if (args.out == nullptr) grid.sync();
    GRID_BAR();

    bf16* R = (bf16*)(ws + WS_R);
    LAS unsigned char* ex = lds + EX_OFF;
    {
        bf16* Qf = R; bf16* Kf = R + (size_t)NTOK * DM; bf16* Vf = R + (size_t)2 * NTOK * DM; bf16* Of = R + (size_t)3 * NTOK * DM;
        { pg8::Gemm g{XB, (const bf16*)(ws + WS_FOX_IN), NTOK, 6144, 2048}; pg8::StaticOrder S; S.init(NTOK, 6144, G, c);
          pg8::EpiQKV E{Qf, Kf, Vf, 8, 2048, args.in[3], args.in[4], 1 << 20, SSP, ex};
          pg8::epi_rs_invalidate(ex); pg8::gemm_phase<pg8::EpiQKV, pg8::StaticOrder, true, true>(lds, g, S, E); }
        int tf_ = threadIdx.x; asm volatile("" : "+v"(tf_));
        for (int task = c * NWAVES + (tf_ >> 6); task < NTOK / 16; task += NGW) {
            const int lane = tf_ & 63, i16 = lane & 15, kq = lane >> 4, tok = 16 * task + i16;
            const bf16* ap = WfT + (size_t)i16 * DM + 8 * kq; const bf16* bp = XB + (size_t)tok * DM + 8 * kq;
            f32x4 acc = {0.f, 0.f, 0.f, 0.f};
#pragma unroll 1
            for (int s0 = 0; s0 < 64; s0 += 16) {
                bf16x8 fa[16], fb[16];
#pragma unroll
                for (int s = 0; s < 16; ++s) { fa[s] = *(const bf16x8*)(ap + 32 * (s0 + s)); fb[s] = *(const bf16x8*)(bp + 32 * (s0 + s)); }
#pragma unroll
                for (int s = 0; s < 16; ++s) acc = __builtin_amdgcn_mfma_f32_16x16x32_bf16(fa[s], fb[s], acc, 0, 0, 0);
            }
            float ss = 0.f;
#pragma unroll
            for (int i = 0; i < 8; ++i) ss += SSP[(size_t)i * NTOK + tok];
            const float rs = rsqrtf(ss * (1.0f / 2048.0f) + 1e-6f);
#pragma unroll
            for (int r = 0; r < 4; ++r) { const int hh = 4 * kq + r; const float z = acc[r] * rs + args.in[2][hh];
                LF[(size_t)hh * NTOK + tok] = fminf(z, 0.f) - log1pf(__expf(-fabsf(z))); }
        }
        GRID_BAR();
        if (c < 32) {
            int tc_ = threadIdx.x; asm volatile("" : "+v"(tc_)); const int tid = tc_, lane = tc_ & 63, wave = tc_ >> 6;
            const int b = c >> 4, h = c & 15; const float* src = LF + (size_t)h * NTOK + (size_t)b * SEQ + 16 * tid; float* dst = D2 + (size_t)c * SEQ + 16 * tid;
            f32x4 v[4]; float run = 0.f;
#pragma unroll
            for (int j = 0; j < 4; ++j) { v[j] = *(const f32x4*)(src + 4 * j);
#pragma unroll
                for (int e = 0; e < 4; ++e) { run += v[j][e]; v[j][e] = run; } }
            float incl = run;
#pragma unroll
            for (int o = 1; o < 64; o <<= 1) { const float t = __shfl_up(incl, o); if (lane >= o) incl += t; }
            LAS float* wt = (LAS float*)lds;
            if (lane == 63) wt[wave] = incl;
            __syncthreads();
            float pre = incl - run;
            for (int ww = 0; ww < wave; ++ww) pre += wt[ww];
#pragma unroll
            for (int j = 0; j < 4; ++j) { f32x4 o;
#pragma unroll
                for (int e = 0; e < 4; ++e) o[e] = -(v[j][e] + pre) * LOG2E;
                *(f32x4*)(dst + 4 * j) = o; }
        }
        GRID_BAR();
        for (int rep = 0; rep < REP_FOX; ++rep) fox_attn_phase(lds, Qf, Of, Kf, Vf, D2, args.in[3], args.in[4], G, c);
        GRID_BAR();
        { pg8::Gemm g{Of, (const bf16*)(ws + WS_FOX_O), NTOK, 2048, 2048}; pg8::StaticOrder S; S.init(NTOK, 2048, G, c);
          pg8::EpiRes E{XB, nullptr, XB, SSP, ex};
          pg8::gemm_phase<pg8::EpiRes, pg8::StaticOrder, true, true>(lds, g, S, E); }
        GRID_BAR();
    }
#define MLP_BLOCK(UPW, DNW, FINAL) do { \
            { pg8::Gemm g{XB, (const bf16*)(ws + (UPW)), NTOK, 8192, 2048}; pg8::StaticOrder S; S.init(NTOK, 8192, G, c); \
              pg8::EpiUp E{R, SSP, ex}; pg8::epi_rs_invalidate(ex); pg8::gemm_phase<pg8::EpiUp, pg8::StaticOrder, true, true>(lds, g, S, E); } \
            GRID_BAR(); \
            { pg8::Gemm g{R, (const bf16*)(ws + (DNW)), NTOK, 2048, 8192}; pg8::StaticOrder S; S.init(NTOK, 2048, G, c); \
              pg8::EpiRes E{XB, (FINAL) ? out : nullptr, (FINAL) ? nullptr : XB, SSP, ex}; pg8::gemm_phase<pg8::EpiRes, pg8::StaticOrder, true, true>(lds, g, S, E); } \
            if (!(FINAL)) GRID_BAR(); } while (0)
    MLP_BLOCK(WS_UP0, WS_DN0, false);
    {
        bf16* Qd = R; bf16* Kd = R + (size_t)NTOK * 3072; bf16* Vd = R + (size_t)2 * NTOK * 3072; bf16* Od = (bf16*)out;
        { pg8::Gemm g{XB, (const bf16*)(ws + WS_DIL_IN), NTOK, 8192, 2048}; pg8::StaticOrder S; S.init(NTOK, 8192, G, c);
          pg8::EpiQKV E{Qd, Kd, Vd, 12, 3072, args.in[7], args.in[8], 4, SSP, ex};
          pg8::epi_rs_invalidate(ex); pg8::gemm_phase<pg8::EpiQKV, pg8::StaticOrder, true, true>(lds, g, S, E); }
        GRID_BAR();
        for (int rep = 0; rep < REP_DIL; ++rep) dil_attn_phase(lds, Qd, Kd, Vd, Od, args.in[7], args.in[8], G, c);
        GRID_BAR();
        { pg8::Gemm g{Od, (const bf16*)(ws + WS_DIL_O), NTOK, 2048, 2048}; pg8::StaticOrder S; S.init(NTOK, 2048, G, c);
          pg8::EpiRes E{XB, nullptr, XB, SSP, ex};
          pg8::gemm_phase<pg8::EpiRes, pg8::StaticOrder, true, true>(lds, g, S, E); }
        GRID_BAR();
        MLP_BLOCK(WS_UP1, WS_DN1, true);
    }
}

extern "C" void kernel_launch(void* const* d_in, const int* in_sizes, int n_in, void* d_out, int out_size, void* d_ws, size_t ws_size, hipStream_t stream) {
    static int grid = 0;
    if (grid == 0) {
        if (n_in != 14 || ws_size < WS_END) { fprintf(stderr, "kernel_launch: need 14 inputs and >= %zu bytes of workspace (got %d, %zu)\n", (size_t)WS_END, n_in, ws_size); grid = -1; return; }
        int dev = 0, cus = 0, per_cu = 0;
        hipGetDevice(&dev); hipDeviceGetAttribute(&cus, hipDeviceAttributeMultiprocessorCount, dev);
        if (hipFuncSetAttribute((const void*)fwd_megakernel, hipFuncAttributeMaxDynamicSharedMemorySize, LDS_BYTES) != hipSuccess) { fprintf(stderr, "kernel_launch: hipFuncSetAttribute failed\n"); grid = -1; return; }
        if (hipOccupancyMaxActiveBlocksPerMultiprocessor(&per_cu, (const void*)fwd_megakernel, NWAVES * 64, LDS_BYTES) != hipSuccess || per_cu < 1) { fprintf(stderr, "kernel_launch: occupancy query gave %d\n", per_cu); per_cu = 1; }
        (void)hipGetLastError();
        grid = cus * 1;
    }
    if (grid < 0) return;
    if (hipMemsetAsync((char*)d_ws + WS_BAR, 0, 16384, stream) != hipSuccess) { fprintf(stderr, "kernel_launch: memset of the barrier words failed\n"); return; }
    Args a{};
    for (int i = 0; i < 14; ++i) a.in[i] = (const float*)d_in[i];
    a.out = (float*)d_out; a.ws = (unsigned char*)d_ws;
    void* kargs[] = {&a};
    hipError_t e = hipLaunchCooperativeKernel((const void*)fwd_megakernel, dim3(grid), dim3(NWAVES * 64), kargs, LDS_BYTES, stream);
    if (e != hipSuccess) fprintf(stderr, "kernel_launch: cooperative launch failed: %s (grid %d)\n", hipGetErrorString(e), grid);
}
```

```cpp
#include <hip/hip_runtime.h>
#include <hip/hip_cooperative_groups.h>
#include <cstdio>
#include <cstdint>
#include <cmath>
namespace cg = cooperative_groups;
namespace pg8 {
#define PG8_LAS __attribute__((address_space(3)))
typedef unsigned short bf16_t;
typedef short bf16x8 __attribute__((ext_vector_type(8)));
typedef float f32x4 __attribute__((ext_vector_type(4)));
typedef unsigned u32x4 __attribute__((ext_vector_type(4)));
constexpr int BM = 256, BK = 64, HALF = 128, HTB = HALF * BK * 2  , STAGE_BYTES = 8 * HTB, NXCD = 8, WGM = 8;

__host__ __device__ __forceinline__ int lds_byte(int r, int c) { const int st = (r >> 4) * 2 + (c >> 5), rr = r & 15, cc = c & 31, ob = rr * 64 + cc * 2; return st * 1024 + (ob ^ (((ob >> 9) & 1) << 5)); }
__host__ __device__ __forceinline__ void stage_rc(int b, int& R, int& C) { const int st = b / 1024, sb = b % 1024, swz = sb ^ (((sb >> 9) & 1) << 5); R = (st >> 1) * 16 + swz / 64; C = (st & 1) * 32 + (swz % 64) / 2; }
__host__ __device__ __forceinline__ int perm32(int rho) { const int n = rho >> 4, i = rho & 15; return 8 * (i >> 2) + 4 * n + (i & 3); }

struct Unit { int pm, pn; };
struct Gemm { const bf16_t* A; const bf16_t* Bt; int M, N, K; };

struct StaticOrder {
    int nM, nN, nwg, G, c;
    __host__ __device__ void init(int M, int N, int G_, int c_) { nM = M / BM; nN = N / BM; nwg = nM * nN; G = G_; c = c_; }
    __host__ __device__ bool next(int i, Unit& u) const {
        const long L = (long)i * G + c; if (L >= nwg) return false;
        int wgid = (int)L; { const int q = nwg / NXCD, r = nwg % NXCD, xcd = wgid % NXCD, off = wgid / NXCD; wgid = (xcd < r ? xcd * (q + 1) : r * (q + 1) + (xcd - r) * q) + off; }
        const int nig = WGM * nN, gid = wgid / nig, fm = gid * WGM, gsz = (nM - fm) < WGM ? (nM - fm) : WGM;
        u.pm = fm + ((wgid % nig) % gsz); u.pn = (wgid % nig) / gsz; return true;
    }
    __device__ __forceinline__ void a_ready(const Unit&) const {}
    __device__ __forceinline__ void done(const Unit&) const {}
};

__device__ __forceinline__ unsigned cvt_pk_bf16(float lo, float hi) { unsigned r; asm volatile("v_cvt_pk_bf16_f32 %0, %1, %2" : "=v"(r) : "v"(lo), "v"(hi)); return r; }
typedef float f32x2 __attribute__((ext_vector_type(2)));
constexpr int TOK = 16384;
__device__ __forceinline__ float sq4(f32x4 v) { return (v[0] * v[0] + v[1] * v[1]) + (v[2] * v[2] + v[3] * v[3]); }
__device__ __forceinline__ bool epi_rs_table(PG8_LAS float* RS, PG8_LAS unsigned char* ex, const float* ssp, int pm) {
    const int tid = threadIdx.x;
    if (*(volatile PG8_LAS int*)(ex + 12288) == pm) return false;
    if (tid < 256) { float s = 0.f;
#pragma unroll
        for (int i = 0; i < 8; ++i) s += ssp[(size_t)i * TOK + pm * BM + tid];
        RS[tid] = rsqrtf(s * (1.0f / 2048.0f) + 1e-6f); }
    return true;
}
__device__ __forceinline__ void epi_rs_commit(PG8_LAS unsigned char* ex, int pm) { if (threadIdx.x == 0) *(volatile PG8_LAS int*)(ex + 12288) = pm; }
__device__ __forceinline__ void epi_rs_invalidate(PG8_LAS unsigned char* ex) { if (threadIdx.x == 0) *(volatile PG8_LAS int*)(ex + 12288) = -1; }
#define EPI_SYNC() do { asm volatile("s_waitcnt lgkmcnt(0)" ::: "memory"); __builtin_amdgcn_s_barrier(); asm volatile("" ::: "memory"); } while (0)

struct EpiQKV {
    static constexpr bool PERM = true, AFTER_DRAIN = false;
    bf16_t *Q, *Kb, *V; int nq, pitch_qk; const float *gq, *gk; int gain_tiles; const float* ssp; PG8_LAS unsigned char* ex;
    __device__ __forceinline__ void operator()(const f32x4 (&acc)[2][2][4][2], const Unit& u, int wr, int wc, int fr, int fq) const {
        PG8_LAS float* RS = (PG8_LAS float*)ex; PG8_LAS float* P = (PG8_LAS float*)(ex + 1024);
        const bool fresh = epi_rs_table(RS, ex, ssp, u.pm);
        const bool isV = u.pn >= 2 * nq;
        if (!isV) {
#pragma unroll
            for (int ai = 0; ai < 2; ++ai)
#pragma unroll
                for (int m = 0; m < 4; ++m)
#pragma unroll
                    for (int bj = 0; bj < 2; ++bj) { float q = sq4(acc[ai][bj][m][0]) + sq4(acc[ai][bj][m][1]); q += __shfl_xor(q, 16); q += __shfl_xor(q, 32);
                        if (fq == 0) P[((ai * HALF + wr * 64 + m * 16 + fr) * 2 + bj) * 4 + wc] = q; }
        }
        if (fresh || !isV) EPI_SYNC();
        if (fresh) epi_rs_commit(ex, u.pm);
        const int d0 = wc * 32 + 8 * fq;
        if (isV) {
            const int colt = (u.pn - 2 * nq) * BM + d0;
#pragma unroll
            for (int ai = 0; ai < 2; ++ai)
#pragma unroll
                for (int m = 0; m < 4; ++m) { const int rl = ai * HALF + wr * 64 + m * 16 + fr; const float rs = RS[rl]; bf16_t* rowp = V + (size_t)(u.pm * BM + rl) * 2048 + colt;
#pragma unroll
                    for (int bj = 0; bj < 2; ++bj) { const f32x4 v0 = acc[ai][bj][m][0] * rs, v1 = acc[ai][bj][m][1] * rs; u32x4 w;
                        w.x = cvt_pk_bf16(v0[0], v0[1]); w.y = cvt_pk_bf16(v0[2], v0[3]); w.z = cvt_pk_bf16(v1[0], v1[1]); w.w = cvt_pk_bf16(v1[2], v1[3]); *(u32x4*)(rowp + bj * HALF) = w; } }
        } else {
            const bool isQ = u.pn < nq; const int tp = isQ ? u.pn : u.pn - nq; const float* gp = (isQ ? gq : gk) + (tp / gain_tiles) * 128 + d0;
            const float qs = isQ ? 0.08838834764831845f * 1.4426950408889634f : 1.0f;
            const f32x4 g0 = *(const f32x4*)gp * qs, g1 = *(const f32x4*)(gp + 4) * qs;
            bf16_t* base = (isQ ? Q : Kb) + tp * BM + d0;
#pragma unroll
            for (int ai = 0; ai < 2; ++ai)
#pragma unroll
                for (int m = 0; m < 4; ++m) { const int rl = ai * HALF + wr * 64 + m * 16 + fr; const float rs = RS[rl]; bf16_t* rowp = base + (size_t)(u.pm * BM + rl) * pitch_qk;
#pragma unroll
                    for (int bj = 0; bj < 2; ++bj) { const f32x4 pp = *(const PG8_LAS f32x4*)(P + (rl * 2 + bj) * 4); const float tot = (pp[0] + pp[1]) + (pp[2] + pp[3]);
                        const float f = rs * rsqrtf(rs * rs * tot * (1.0f / 128.0f) + 1e-6f);
                        const f32x4 v0 = acc[ai][bj][m][0] * f * g0, v1 = acc[ai][bj][m][1] * f * g1; u32x4 w;
                        w.x = cvt_pk_bf16(v0[0], v0[1]); w.y = cvt_pk_bf16(v0[2], v0[3]); w.z = cvt_pk_bf16(v1[0], v1[1]); w.w = cvt_pk_bf16(v1[2], v1[3]); *(u32x4*)(rowp + bj * HALF) = w; } }
        }
    }
};
struct EpiUp {
    static constexpr bool PERM = true, AFTER_DRAIN = false;
    bf16_t* H; const float* ssp; PG8_LAS unsigned char* ex;
    __device__ __forceinline__ void operator()(const f32x4 (&acc)[2][2][4][2], const Unit& u, int wr, int wc, int fr, int fq) const {
        PG8_LAS float* RS = (PG8_LAS float*)ex;
        if (epi_rs_table(RS, ex, ssp, u.pm)) { EPI_SYNC(); epi_rs_commit(ex, u.pm); }
        const int col0 = u.pn * BM + wc * 32 + 8 * fq;
#pragma unroll
        for (int ai = 0; ai < 2; ++ai)
#pragma unroll
            for (int m = 0; m < 4; ++m) { const int rl = ai * HALF + wr * 64 + m * 16 + fr; const float rs = RS[rl]; bf16_t* rowp = H + (size_t)(u.pm * BM + rl) * 8192 + col0;
#pragma unroll
                for (int bj = 0; bj < 2; ++bj) { f32x4 v0 = acc[ai][bj][m][0] * rs, v1 = acc[ai][bj][m][1] * rs;
#pragma unroll
                    for (int j = 0; j < 4; ++j) { v0[j] = fmaxf(v0[j], 0.f); v1[j] = fmaxf(v1[j], 0.f); }
                    v0 = v0 * v0; v1 = v1 * v1; u32x4 w;
                    w.x = cvt_pk_bf16(v0[0], v0[1]); w.y = cvt_pk_bf16(v0[2], v0[3]); w.z = cvt_pk_bf16(v1[0], v1[1]); w.w = cvt_pk_bf16(v1[2], v1[3]); *(u32x4*)(rowp + bj * HALF) = w; } }
    }
};
struct EpiRes {
    static constexpr bool PERM = true, AFTER_DRAIN = false;
    const bf16_t* base; float* out; bf16_t* xb; float* ssp; PG8_LAS unsigned char* ex;
    __device__ __forceinline__ void operator()(const f32x4 (&acc)[2][2][4][2], const Unit& u, int wr, int wc, int fr, int fq) const {
        PG8_LAS float* P = (PG8_LAS float*)(ex + 1024);
        const int col0 = u.pn * BM + wc * 32 + 8 * fq;
#pragma unroll
        for (int ai = 0; ai < 2; ++ai)
#pragma unroll
            for (int m = 0; m < 4; ++m) { const int rl = ai * HALF + wr * 64 + m * 16 + fr; const size_t off = (size_t)(u.pm * BM + rl) * 2048 + col0; float q = 0.f;
#pragma unroll
                for (int bj = 0; bj < 2; ++bj) { const u32x4 bw = *(const u32x4*)(base + off + bj * HALF);
                    f32x4 v0, v1;
                    v0[0] = __builtin_bit_cast(float, bw.x << 16); v0[1] = __builtin_bit_cast(float, bw.x & 0xffff0000u); v0[2] = __builtin_bit_cast(float, bw.y << 16); v0[3] = __builtin_bit_cast(float, bw.y & 0xffff0000u);
                    v1[0] = __builtin_bit_cast(float, bw.z << 16); v1[1] = __builtin_bit_cast(float, bw.z & 0xffff0000u); v1[2] = __builtin_bit_cast(float, bw.w << 16); v1[3] = __builtin_bit_cast(float, bw.w & 0xffff0000u);
                    v0 = v0 + acc[ai][bj][m][0]; v1 = v1 + acc[ai][bj][m][1];
                    if (out) { *(f32x4*)(out + off + bj * HALF) = v0; *(f32x4*)(out + off + bj * HALF + 4) = v1; }
                    q += sq4(v0) + sq4(v1);
                    if (xb) { u32x4 w; w.x = cvt_pk_bf16(v0[0], v0[1]); w.y = cvt_pk_bf16(v0[2], v0[3]); w.z = cvt_pk_bf16(v1[0], v1[1]); w.w = cvt_pk_bf16(v1[2], v1[3]); *(u32x4*)(xb + off + bj * HALF) = w; } }
                q += __shfl_xor(q, 16); q += __shfl_xor(q, 32);
                if (fq == 0) P[rl * 4 + wc] = q; }
        EPI_SYNC();
        const int tid = threadIdx.x;
        if (tid < 256) { const f32x4 pp = *(const PG8_LAS f32x4*)(P + tid * 4); ssp[(size_t)u.pn * TOK + u.pm * BM + tid] = (pp[0] + pp[1]) + (pp[2] + pp[3]); }
    }
};

template <class Epi, class Sched, bool ALIGN_EPI = false, bool SP2 = false>
__device__ __forceinline__ void gemm_phase(PG8_LAS unsigned char* lds, const Gemm g, const Sched& S, const Epi& E) {
    int tid_ = threadIdx.x; asm volatile("" : "+v"(tid_));
    const int tid = tid_, wid = __builtin_amdgcn_readfirstlane(tid >> 6), lane = tid & 63, wr = wid >> 2, wc = wid & 3, fr = lane & 15, fq = lane >> 4;
    const int K = g.K, nt = K / BK;
    unsigned voffA[2], voffB[2];
#pragma unroll
    for (int i = 0; i < 2; ++i) { int R, C; stage_rc(tid * 16 + i * 8192, R, C); const int Rb = Epi::PERM ? ((R & ~31) + perm32(R & 31)) : R;
        voffA[i] = (unsigned)(R * K + C) * 2u; voffB[i] = (unsigned)(Rb * K + C) * 2u; }
    const size_t kstep = (size_t)(BK * 2);
    const size_t hstep = (size_t)HALF * K * 2;
    const size_t tstep = 2 * hstep;
    const unsigned ldsw = (unsigned)wid * 1024u;
    const int aoff = lds_byte(wr * 64 + fr, fq * 8), boff = lds_byte(wc * 32 + fr, fq * 8);
#define PG8_SA(b, h) (((b) * 2 + (h)) * HTB)
#define PG8_SB(b, h) ((4 + (b) * 2 + (h)) * HTB)
#define PG8_STAGE(bufoff, gbase, voff) do { _Pragma("unroll") for (int _i = 0; _i < 2; ++_i) \
        __builtin_amdgcn_global_load_lds((const unsigned*)((const char*)(gbase) + (voff)[_i]), (PG8_LAS unsigned*)(lds + (bufoff) + ldsw + _i * 8192), 16, 0, 0); } while (0)
#define PG8_LDA(dst, b, h) do { _Pragma("unroll") for (int m = 0; m < 4; ++m) _Pragma("unroll") for (int k = 0; k < 2; ++k) dst[m][k] = *(const PG8_LAS bf16x8*)(lds + PG8_SA(b, h) + aoff + m * 2048 + k * 1024); } while (0)
#define PG8_LDB(dst, b, h) do { _Pragma("unroll") for (int n = 0; n < 2; ++n) _Pragma("unroll") for (int k = 0; k < 2; ++k) dst[n][k] = *(const PG8_LAS bf16x8*)(lds + PG8_SB(b, h) + boff + n * 2048 + k * 1024); } while (0)
#define PG8_MMA(ai, bj, At, Bt) do { __builtin_amdgcn_s_setprio(1); _Pragma("unroll") for (int m = 0; m < 4; ++m) _Pragma("unroll") for (int n = 0; n < 2; ++n) _Pragma("unroll") for (int k = 0; k < 2; ++k) \
        acc[ai][bj][m][n] = __builtin_amdgcn_mfma_f32_16x16x32_bf16(Bt[n][k], At[m][k], acc[ai][bj][m][n], 0, 0, 0); __builtin_amdgcn_s_setprio(0); } while (0)
#define PG8_WAIT_V(n) asm volatile("s_waitcnt vmcnt(" #n ")" ::: "memory")
#define PG8_WAIT_L(n) asm volatile("s_waitcnt lgkmcnt(" #n ")" ::: "memory")
#define PG8_BAR __builtin_amdgcn_s_barrier()
#define PG8_SCHED __builtin_amdgcn_sched_barrier(0)
    Unit cur, nxt; int ui = 0;
    if (!S.next(0, cur)) return;
    f32x4 acc[2][2][4][2];
#pragma unroll
    for (int a = 0; a < 2; ++a)
#pragma unroll
        for (int b = 0; b < 2; ++b)
#pragma unroll
            for (int m = 0; m < 4; ++m)
#pragma unroll
                for (int n = 0; n < 2; ++n) acc[a][b][m][n] = (f32x4){0.f, 0.f, 0.f, 0.f};
    bf16x8 At[4][2], B0[2][2], B1[2][2];
    const char* cA = (const char*)g.A + (size_t)cur.pm * tstep; const char* cB = (const char*)g.Bt + (size_t)cur.pn * tstep;
    S.a_ready(cur);
    if constexpr (SP2) {
        PG8_STAGE(PG8_SB(0, 0), cB, voffB); PG8_STAGE(PG8_SB(0, 1), cB + hstep, voffB); PG8_STAGE(PG8_SA(0, 0), cA, voffA); PG8_STAGE(PG8_SA(0, 1), cA + hstep, voffA);
        if (wr == 1) PG8_BAR;
        PG8_WAIT_V(2); PG8_BAR;
        PG8_STAGE(PG8_SB(1, 0), cB + kstep, voffB); PG8_STAGE(PG8_SA(1, 0), cA + kstep, voffA); PG8_STAGE(PG8_SB(1, 1), cB + hstep + kstep, voffB);
        PG8_WAIT_V(6); PG8_BAR;
    } else {
        PG8_STAGE(PG8_SB(0, 0), cB, voffB); PG8_STAGE(PG8_SA(0, 0), cA, voffA); PG8_STAGE(PG8_SB(0, 1), cB + hstep, voffB); PG8_STAGE(PG8_SA(0, 1), cA + hstep, voffA);
        if (wr == 1) PG8_BAR;
        PG8_WAIT_V(4); PG8_BAR;
        PG8_STAGE(PG8_SB(1, 0), cB + kstep, voffB); PG8_STAGE(PG8_SA(1, 0), cA + kstep, voffA); PG8_STAGE(PG8_SB(1, 1), cB + hstep + kstep, voffB);
        PG8_WAIT_V(6); PG8_BAR;
    }
    for (;;) {
        const bool has_next = S.next(ui + 1, nxt);
        const char* nA = has_next ? (const char*)g.A + (size_t)nxt.pm * tstep : cA; const char* nB = has_next ? (const char*)g.Bt + (size_t)nxt.pn * tstep : cB;
        for (int t = 0; t < nt; t += 2) {
            const bool last = (t == nt - 2);
            const char* a1 = cA + (size_t)(t + 1) * kstep;
            const char* a2 = last ? nA : cA + (size_t)(t + 2) * kstep; const char* b2 = last ? nB : cB + (size_t)(t + 2) * kstep;
            const char* a3 = a2 + kstep; const char* b3 = b2 + kstep;
            if (last && has_next) S.a_ready(nxt);
            if constexpr (SP2) {
            PG8_LDB(B0, 0, 0); PG8_LDB(B1, 0, 1); PG8_SCHED; PG8_LDA(At, 0, 0); PG8_STAGE(PG8_SA(1, 1), a1 + hstep, voffA);
            PG8_WAIT_V(8); PG8_WAIT_L(0); PG8_BAR; PG8_MMA(0, 0, At, B0); PG8_MMA(0, 1, At, B1); PG8_BAR; PG8_SCHED;
            PG8_LDA(At, 0, 1); PG8_STAGE(PG8_SB(0, 0), b2, voffB); PG8_STAGE(PG8_SB(0, 1), b2 + hstep, voffB); PG8_STAGE(PG8_SA(0, 0), a2, voffA);
            PG8_WAIT_V(8); PG8_WAIT_L(0); PG8_BAR; PG8_MMA(1, 0, At, B0); PG8_MMA(1, 1, At, B1); PG8_BAR; PG8_SCHED;
            PG8_LDB(B0, 1, 0); PG8_LDB(B1, 1, 1); PG8_SCHED; PG8_LDA(At, 1, 0); PG8_STAGE(PG8_SA(0, 1), a2 + hstep, voffA);
            PG8_WAIT_V(8); PG8_WAIT_L(0); PG8_BAR; PG8_MMA(0, 0, At, B0); PG8_MMA(0, 1, At, B1); PG8_BAR; PG8_SCHED;
            PG8_LDA(At, 1, 1); PG8_STAGE(PG8_SB(1, 0), b3, voffB); PG8_STAGE(PG8_SB(1, 1), b3 + hstep, voffB); PG8_STAGE(PG8_SA(1, 0), a3, voffA);
            PG8_WAIT_V(8); PG8_WAIT_L(0); PG8_BAR; PG8_MMA(1, 0, At, B0); PG8_MMA(1, 1, At, B1); PG8_BAR; PG8_SCHED;
            } else {
            PG8_LDB(B0, 0, 0); PG8_SCHED; PG8_LDA(At, 0, 0); PG8_STAGE(PG8_SA(1, 1), a1 + hstep, voffA);
            PG8_WAIT_L(8); PG8_BAR; PG8_WAIT_L(0); PG8_MMA(0, 0, At, B0); PG8_BAR; PG8_SCHED;
            PG8_LDB(B1, 0, 1); PG8_STAGE(PG8_SB(0, 0), b2, voffB);
            PG8_BAR; PG8_WAIT_L(0); PG8_MMA(0, 1, At, B1); PG8_BAR;
            PG8_LDA(At, 0, 1); PG8_STAGE(PG8_SA(0, 0), a2, voffA);
            PG8_BAR; PG8_WAIT_L(0); PG8_MMA(1, 0, At, B0); PG8_BAR; PG8_SCHED;
            PG8_STAGE(PG8_SB(0, 1), b2 + hstep, voffB);
            PG8_WAIT_V(6); PG8_BAR; PG8_MMA(1, 1, At, B1); PG8_BAR;
            PG8_LDB(B0, 1, 0); PG8_SCHED; PG8_LDA(At, 1, 0); PG8_STAGE(PG8_SA(0, 1), a2 + hstep, voffA);
            PG8_WAIT_L(8); PG8_BAR; PG8_WAIT_L(0); PG8_MMA(0, 0, At, B0); PG8_BAR; PG8_SCHED;
            PG8_LDB(B1, 1, 1); PG8_STAGE(PG8_SB(1, 0), b3, voffB);
            PG8_BAR; PG8_WAIT_L(0); PG8_MMA(0, 1, At, B1); PG8_BAR;
            PG8_LDA(At, 1, 1); PG8_STAGE(PG8_SA(1, 0), a3, voffA);
            PG8_BAR; PG8_WAIT_L(0); PG8_MMA(1, 0, At, B0); PG8_BAR; PG8_SCHED;
            PG8_STAGE(PG8_SB(1, 1), b3 + hstep, voffB);
            PG8_WAIT_V(6); PG8_BAR; PG8_MMA(1, 1, At, B1); PG8_BAR;
            }
        }
        if constexpr (ALIGN_EPI) { if (wr == 0) PG8_BAR; }
        if constexpr (!Epi::AFTER_DRAIN) { E(acc, cur, wr, wc, fr, fq); S.done(cur); }
        if (!has_next) break;
#pragma unroll
        for (int a = 0; a < 2; ++a)
#pragma unroll
            for (int b = 0; b < 2; ++b)
#pragma unroll
                for (int m = 0; m < 4; ++m)
#pragma unroll
                    for (int n = 0; n < 2; ++n) acc[a][b][m][n] = (f32x4){0.f, 0.f, 0.f, 0.f};
        cur = nxt; cA = nA; cB = nB; ++ui;
        if constexpr (ALIGN_EPI) { if (wr == 1) PG8_BAR; }
    }
    PG8_WAIT_V(0);
    if constexpr (!ALIGN_EPI) { if (wr == 0) PG8_BAR; }
    PG8_BAR;
    if constexpr (Epi::AFTER_DRAIN) { E.fused(acc, cur, wr, wc, fr, fq, lds, wid, lane); S.done(cur); }
#undef PG8_SA
#undef PG8_SB
#undef PG8_STAGE
#undef PG8_LDA
#undef PG8_LDB
#undef PG8_MMA
#undef PG8_WAIT_V
#undef PG8_WAIT_L
#undef PG8_BAR
#undef PG8_SCHED
}
}
#define LAS __attribute__((address_space(3)))
typedef unsigned short bf16;
typedef short s16x4 __attribute__((ext_vector_type(4)));
typedef short bf16x8 __attribute__((ext_vector_type(8)));
typedef float f32x4 __attribute__((ext_vector_type(4)));
typedef float f32x16 __attribute__((ext_vector_type(16)));
typedef unsigned u32x2 __attribute__((ext_vector_type(2)));
typedef unsigned u32x4 __attribute__((ext_vector_type(4)));
constexpr int SEQ = 8192, NTOK = 16384, DM = 2048;
constexpr float LOG2E = 1.4426950408889634f;
__device__ __forceinline__ unsigned cvtpk(float lo, float hi) { unsigned r; asm volatile("v_cvt_pk_bf16_f32 %0, %1, %2" : "=v"(r) : "v"(lo), "v"(hi)); return r; }
__device__ __forceinline__ unsigned offb(unsigned row, unsigned ch) { return 256u * row + 16u * (ch ^ (((row & 3) << 2) | ((row >> 2) & 3))); }
__device__ __forceinline__ int pislot(int rho) { const int a = rho >> 3, h = (rho >> 2) & 1, c = rho & 3; return 16 * (a >> 1) + 8 * h + 4 * (a & 1) + c; }
__device__ __forceinline__ bf16x8 pack8(const f32x16& s, int base) {
    u32x4 w; w.x = cvtpk(s[base + 0], s[base + 1]); w.y = cvtpk(s[base + 2], s[base + 3]); w.z = cvtpk(s[base + 4], s[base + 5]); w.w = cvtpk(s[base + 6], s[base + 7]);
    return __builtin_bit_cast(bf16x8, w); }
__device__ __forceinline__ bf16x8 tr8(LAS unsigned char* p0, LAS unsigned char* p1) {
    const s16x4 a = __builtin_amdgcn_ds_read_tr16_b64_v4i16((LAS s16x4*)p0), b = __builtin_amdgcn_ds_read_tr16_b64_v4i16((LAS s16x4*)p1);
    bf16x8 v; v.s0 = a.x; v.s1 = a.y; v.s2 = a.z; v.s3 = a.w; v.s4 = b.x; v.s5 = b.y; v.s6 = b.z; v.s7 = b.w; return v; }

__device__ __forceinline__ void fox_attn_phase(LAS unsigned char* lds, const bf16* Q, bf16* Oo, const bf16* K, const bf16* V, const float* D2, const float* gq, const float* gk, int G, int c) {
    int tid_ = threadIdx.x; asm volatile("" : "+v"(tid_));
    const int tid = tid_, lane = tid & 63, w = __builtin_amdgcn_readfirstlane(tid >> 6), hi = lane >> 5, l32 = lane & 31;
    float mq = 0.f, mk = 0.f;
    for (int i = 0; i < 128; ++i) { mq = fmaxf(mq, fabsf(gq[i])); mk = fmaxf(mk, fabsf(gk[i])); }
    const float B2 = 1.03f * 11.313708499f * LOG2E * mq * mk, PRUNE = 2.0f * B2 + 40.0f;
    const unsigned krow = (unsigned)pislot(l32), kx = ((krow & 3) << 2) | ((krow >> 2) & 3);
    unsigned kaddr[8];
#pragma unroll
    for (int s = 0; s < 8; ++s) kaddr[s] = 256u * krow + 16u * ((unsigned)(2 * s + hi) ^ kx);
    unsigned vaddr[4][2];
    { const unsigned blk = (lane >> 4) & 1, q4 = (lane & 15) >> 2, p = lane & 3;
#pragma unroll
      for (int cc = 0; cc < 4; ++cc)
#pragma unroll
        for (int t = 0; t < 2; ++t) vaddr[cc][t] = 16384u + offb(8 * hi + 4 * t + q4, 4 * cc + 2 * blk + (p >> 1)) + 8 * (p & 1); }
    const int srow = tid >> 4, sch = tid & 15;
    const unsigned soff0 = offb(srow, sch), soff1 = offb(srow + 32, sch);
    for (int it = 0;; ++it) {
        const int L = it * G + ((it & 1) ? (G - 1 - c) : c); if (L >= 1024) break;
        const int qb = 31 - (L >> 5), bh = L & 31, b = bh >> 4, h = bh & 15;
        const int q0 = 256 * qb, q0w = q0 + 32 * w, jend = 4 * qb + 3, jwl = (q0w + 31) >> 6;
        const size_t tok0 = (size_t)b * SEQ;
        const float* d2 = D2 + (size_t)bh * SEQ;
        const bf16* Qp = Q + (tok0 + q0w + l32) * DM + h * 128 + 8 * hi;
        bf16x8 qf[8];
#pragma unroll
        for (int s = 0; s < 8; ++s) qf[s] = *(const bf16x8*)(Qp + 16 * s);
        const int jstart = 0;
        const bf16* Kg = K + (tok0 + srow) * DM + h * 128 + sch * 8;
        const bf16* Vg = V + (tok0 + srow) * DM + h * 128 + sch * 8;
        u32x4 pk0, pk1, pv0, pv1; float pd = 0.f;
#define FOX_LOAD(J) do { const size_t o_ = (size_t)(64 * (J)) * DM; pk0 = *(const u32x4*)(Kg + o_); pk1 = *(const u32x4*)(Kg + o_ + 32 * DM); pv0 = *(const u32x4*)(Vg + o_); pv1 = *(const u32x4*)(Vg + o_ + 32 * DM); \
        if (tid < 64) pd = d2[64 * (J) + tid]; } while (0)
#define FOX_STORE(BUF) do { LAS unsigned char* b_ = lds + (BUF) * 33024; *(LAS u32x4*)(b_ + soff0) = pk0; *(LAS u32x4*)(b_ + soff1) = pk1; *(LAS u32x4*)(b_ + 16384 + soff0) = pv0; *(LAS u32x4*)(b_ + 16384 + soff1) = pv1; \
        if (tid < 64) *(LAS float*)(b_ + 32768 + 4 * tid) = pd; } while (0)
        FOX_LOAD(jend);
        f32x16 O[4];
#pragma unroll
        for (int cc = 0; cc < 4; ++cc)
#pragma unroll
            for (int r = 0; r < 16; ++r) O[cc][r] = 0.f;
        float lrun = 0.f;
        const int qpos = q0w + l32;
        const float d2q = d2[qpos], mfix = d2q + B2;
        LAS float* red = (LAS float*)(lds + 2 * 33024);
        __syncthreads();
        FOX_STORE(jend & 1);
        if (jstart < jend) FOX_LOAD(jend - 1);
        __syncthreads();
        for (int j = jend; j >= jstart; --j) {
            if (j > jstart) FOX_STORE((j - 1) & 1);
            if (j - 1 > jstart) FOX_LOAD(j - 2);
            LAS unsigned char* tb = lds + (j & 1) * 33024;
            const float bound = d2[64 * (j > 0 ? j : 1) - 1] + __builtin_amdgcn_logf((float)(64 * (j > 0 ? j : 1))) + 24.0f;
            if (j <= jwl) {
                f32x16 S0, S1;
                { const LAS float* dl = (const LAS float*)(tb + 32768) + 8 * hi;
                  const f32x4 a0 = *(const LAS f32x4*)(dl), a1 = *(const LAS f32x4*)(dl + 4), a2 = *(const LAS f32x4*)(dl + 16), a3 = *(const LAS f32x4*)(dl + 20);
                  const f32x4 b0 = *(const LAS f32x4*)(dl + 32), b1 = *(const LAS f32x4*)(dl + 36), b2 = *(const LAS f32x4*)(dl + 48), b3 = *(const LAS f32x4*)(dl + 52);
#pragma unroll
                  for (int e = 0; e < 4; ++e) { S0[e] = a0[e]; S0[4 + e] = a1[e]; S0[8 + e] = a2[e]; S0[12 + e] = a3[e]; S1[e] = b0[e]; S1[4 + e] = b1[e]; S1[8 + e] = b2[e]; S1[12 + e] = b3[e]; } }
#pragma unroll
                for (int hb = 0; hb < 2; ++hb) {
                    bf16x8 ka[4], kc[4];
#pragma unroll
                    for (int s = 0; s < 4; ++s) { ka[s] = *(const LAS bf16x8*)(tb + kaddr[4 * hb + s]); kc[s] = *(const LAS bf16x8*)(tb + kaddr[4 * hb + s] + 8192); }
                    __builtin_amdgcn_sched_barrier(0);
#pragma unroll
                    for (int s = 0; s < 4; ++s) { S0 = __builtin_amdgcn_mfma_f32_32x32x16_bf16(ka[s], qf[4 * hb + s], S0, 0, 0, 0); S1 = __builtin_amdgcn_mfma_f32_32x32x16_bf16(kc[s], qf[4 * hb + s], S1, 0, 0, 0); }
                    __builtin_amdgcn_sched_barrier(0);
                }
                if (64 * j + 63 > q0w) {
                    const int kb = 64 * j + 8 * hi;
#pragma unroll
                    for (int r = 0; r < 16; ++r) { const int key = kb + 16 * (r >> 3) + (r & 7); if (key > qpos) S0[r] = -INFINITY; if (key + 32 > qpos) S1[r] = -INFINITY; }
                }
                float ps = 0.f;
#pragma unroll
                for (int r = 0; r < 16; ++r) { S0[r] = __builtin_amdgcn_exp2f(S0[r] - mfix); S1[r] = __builtin_amdgcn_exp2f(S1[r] - mfix); ps += S0[r] + S1[r]; }
                lrun += ps;
                bf16x8 P[4]; P[0] = pack8(S0, 0); P[1] = pack8(S0, 8); P[2] = pack8(S1, 0); P[3] = pack8(S1, 8);
                { bf16x8 va[4], vb[4];
#pragma unroll
                  for (int cc = 0; cc < 4; ++cc) va[cc] = tr8(tb + vaddr[cc][0], tb + vaddr[cc][1]);
#pragma unroll
                  for (int ks = 0; ks < 4; ++ks) {
                      if (ks < 3) {
#pragma unroll
                          for (int cc = 0; cc < 4; ++cc) { const bf16x8 t = tr8(tb + vaddr[cc][0] + 4096 * (ks + 1), tb + vaddr[cc][1] + 4096 * (ks + 1)); if (ks & 1) va[cc] = t; else vb[cc] = t; } }
                      __builtin_amdgcn_sched_barrier(0);
#pragma unroll
                      for (int cc = 0; cc < 4; ++cc) O[cc] = __builtin_amdgcn_mfma_f32_32x32x16_bf16((ks & 1) ? vb[cc] : va[cc], P[ks], O[cc], 0, 0, 0);
                      __builtin_amdgcn_sched_barrier(0);
                  } }
            }
            {
              const int okw = __all(bound <= __builtin_amdgcn_logf(lrun) + d2q);
              if (lane == 0) red[(j & 1) * 8 + w] = okw ? 1.0f : 0.0f; }
            __syncthreads();
            if (j > jstart) {
                const f32x4 ra = *(const LAS f32x4*)(red + (j & 1) * 8), rb = *(const LAS f32x4*)(red + (j & 1) * 8 + 4);
                const float mall = fminf(fminf(fminf(ra[0], ra[1]), fminf(ra[2], ra[3])), fminf(fminf(rb[0], rb[1]), fminf(rb[2], rb[3])));
                if (mall > 0.5f) break;
            }
        }
#undef FOX_LOAD
#undef FOX_STORE
        lrun += __shfl_xor(lrun, 32);
        const float inv = 1.0f / lrun;
        bf16* Op = Oo + (tok0 + q0w + l32) * DM + h * 128 + 4 * hi;
#pragma unroll
        for (int cc = 0; cc < 4; ++cc)
#pragma unroll
            for (int g = 0; g < 4; ++g) { u32x2 wv; wv.x = cvtpk(O[cc][4 * g] * inv, O[cc][4 * g + 1] * inv); wv.y = cvtpk(O[cc][4 * g + 2] * inv, O[cc][4 * g + 3] * inv);
                *(u32x2*)(Op + 32 * cc + 8 * g) = wv; }
    }
    __syncthreads();
}
__device__ __forceinline__ void lds_k4(bf16x8 (&k)[4], unsigned a0, unsigned a1, unsigned a2, unsigned a3) {
    asm volatile("ds_read_b128 %0, %4\n\tds_read_b128 %1, %5\n\tds_read_b128 %2, %6\n\tds_read_b128 %3, %7\n\ts_waitcnt lgkmcnt(0)"
                 : "=&v"(k[0]), "=&v"(k[1]), "=&v"(k[2]), "=&v"(k[3]) : "v"(a0), "v"(a1), "v"(a2), "v"(a3) : "memory");
}
template <int OFF> __device__ __forceinline__ void lds_v4(bf16x8 (&v)[4], unsigned a0, unsigned a1, unsigned b0, unsigned b1) {
    s16x4 r0, r1, r2, r3, r4, r5, r6, r7;
    asm volatile("ds_read_b64_tr_b16 %0, %8 offset:%12\n\tds_read_b64_tr_b16 %1, %9 offset:%12\n\tds_read_b64_tr_b16 %2, %8 offset:%13\n\tds_read_b64_tr_b16 %3, %9 offset:%13\n\t"
                 "ds_read_b64_tr_b16 %4, %10 offset:%12\n\tds_read_b64_tr_b16 %5, %11 offset:%12\n\tds_read_b64_tr_b16 %6, %10 offset:%13\n\tds_read_b64_tr_b16 %7, %11 offset:%13\n\ts_waitcnt lgkmcnt(0)"
                 : "=&v"(r0), "=&v"(r1), "=&v"(r2), "=&v"(r3), "=&v"(r4), "=&v"(r5), "=&v"(r6), "=&v"(r7) : "v"(a0), "v"(a1), "v"(b0), "v"(b1), "i"(OFF), "i"(OFF + 4096) : "memory");
    v[0] = __builtin_shufflevector(r0, r1, 0, 1, 2, 3, 4, 5, 6, 7); v[1] = __builtin_shufflevector(r2, r3, 0, 1, 2, 3, 4, 5, 6, 7);
    v[2] = __builtin_shufflevector(r4, r5, 0, 1, 2, 3, 4, 5, 6, 7); v[3] = __builtin_shufflevector(r6, r7, 0, 1, 2, 3, 4, 5, 6, 7);
}
__device__ __forceinline__ void dil_pv_asm(f32x16 (&Oa)[8], unsigned vt, unsigned va0, unsigned va1, const bf16x8 (&P)[2]) {
    bf16x8 v[4];
#define DIL_PV4(C0, OFF, X0, X1) do { lds_v4<OFF>(v, vt + (va0 ^ (X0)), vt + (va1 ^ (X0)), vt + (va0 ^ (X1)), vt + (va1 ^ (X1))); \
        Oa[C0] = __builtin_amdgcn_mfma_f32_32x32x16_bf16(v[0], P[0], Oa[C0], 0, 0, 0); Oa[C0 + 1] = __builtin_amdgcn_mfma_f32_32x32x16_bf16(v[2], P[0], Oa[C0 + 1], 0, 0, 0); \
        Oa[C0] = __builtin_amdgcn_mfma_f32_32x32x16_bf16(v[1], P[1], Oa[C0], 0, 0, 0); Oa[C0 + 1] = __builtin_amdgcn_mfma_f32_32x32x16_bf16(v[3], P[1], Oa[C0 + 1], 0, 0, 0); \
        asm volatile("" : "+v"(va0), "+v"(va1)); } while (0)
    DIL_PV4(0, 0, 0u, 64u); DIL_PV4(2, 0, 128u, 192u); DIL_PV4(4, 8192, 0u, 64u); DIL_PV4(6, 8192, 128u, 192u);
#undef DIL_PV4
}
template <int RG> __device__ __forceinline__ void dil_cinit(f32x16& S, int kb0, int tq, int hi, float slope2, float mfix) {
    const float base = -slope2 * (float)(tq - kb0 - RG * 8 * hi) - mfix;
#pragma unroll
    for (int r = 0; r < 16; ++r) S[r] = __builtin_fmaf(slope2, (float)(RG * (16 * (r >> 3) + (r & 7))), base);
}
template <int RG> __device__ __forceinline__ void dil_softmax(f32x16& S, int kb0, int tq, int hi, float& lrun, bf16x8 (&P)[2]) {
    const int d0 = tq - kb0 - RG * 8 * hi; const unsigned lim = (unsigned)(tq < 128 * RG ? tq : 128 * RG);
    float ps = 0.f;
#pragma unroll
    for (int r = 0; r < 16; ++r) { const unsigned dist = (unsigned)(d0 - RG * (16 * (r >> 3) + (r & 7)));
        const float e = __builtin_amdgcn_exp2f(S[r]); S[r] = (dist <= lim) ? e : 0.f; ps += S[r]; }
    lrun += ps; P[0] = pack8(S, 0); P[1] = pack8(S, 8);
}
__device__ __forceinline__ void dil_pv(f32x16 (&Oa)[8], LAS unsigned char* vt, unsigned va0, unsigned va1, const bf16x8 (&P)[2]) {
    asm volatile("" : "+v"(va0), "+v"(va1));
#pragma unroll
    for (int cc = 0; cc < 8; ++cc)
#pragma unroll
        for (int ks = 0; ks < 2; ++ks) { LAS unsigned char* vb = vt + (cc >> 2) * 8192 + 4096 * ks;
            const bf16x8 vf = tr8(vb + (va0 ^ ((cc & 3) << 6)), vb + (va1 ^ ((cc & 3) << 6)));
            Oa[cc] = __builtin_amdgcn_mfma_f32_32x32x16_bf16(vf, P[ks], Oa[cc], 0, 0, 0); }
}
template <int RG, int NBLK, int NSTREAM, int BPS  >
__device__ __forceinline__ void dil_shared_group(LAS unsigned char* lds_all, f32x16 (&Oa)[8], float& lrun, const bf16* Qp, const bf16* Kg  , const bf16* Vg  ,
                                                 int tokb0  , int tq, int w, int lane, int hi, const unsigned kbase, const unsigned kx, const unsigned va0, const unsigned va1, float slope2, float mfix) {
    constexpr int NW = 8 / NSTREAM, NSLOT = 24 / NW, NSTEP = NBLK / BPS, BUFB = BPS * 24576;
    static_assert(NBLK % BPS == 0, "blocks per step");
    const int stream = (NSTREAM == 1) ? 0 : (w >> 2), wi = w & (NW - 1);
    LAS unsigned char* sb = lds_all + stream * (2 * BUFB);
    const int drow = lane >> 4, dchp = lane & 15;
    bf16x8 qf[8];
#pragma unroll
    for (int s = 0; s < 8; ++s) qf[s] = *(const bf16x8*)(Qp + 16 * s);
#define DIL_TDMA(M, BUF) do { _Pragma("unroll") for (int bb_ = 0; bb_ < BPS; ++bb_) { const int tb_ = tokb0 + RG * 32 * ((M) * BPS + bb_); _Pragma("unroll") for (int q_ = 0; q_ < NSLOT; ++q_) { const int slot_ = wi + NW * q_; \
        const int row_ = 4 * (slot_ & 7) + drow; const int tk_ = tb_ + RG * row_; const int ch_ = dchp ^ (((row_ & 3) << 2) | ((row_ >> 2) & 3)); \
        const bf16* src_ = (slot_ < 8) ? (Kg + (long)tk_ * 3072 + ch_ * 8) : (Vg + (long)tk_ * DM + ((slot_ - 8) >> 3) * 128 + ch_ * 8); \
        __builtin_amdgcn_global_load_lds((const unsigned*)src_, (LAS unsigned*)(sb + (BUF) * BUFB + bb_ * 24576 + slot_ * 1024), 16, 0, 0); } } } while (0)
    DIL_TDMA(0, 0);
    asm volatile("s_waitcnt vmcnt(0)" ::: "memory");
    __syncthreads();
#pragma unroll 1
    for (int m = 0; m < NSTEP; ++m) {
        if (m + 1 < NSTEP) DIL_TDMA(m + 1, (m + 1) & 1);
#pragma unroll
        for (int bb = 0; bb < BPS; ++bb) {
            LAS unsigned char* tb = sb + (m & 1) * BUFB + bb * 24576;
            const int kb0 = tokb0 + RG * 32 * (m * BPS + bb);
            if (kb0 + RG * 31 >= 0) {
                f32x16 S;
                dil_cinit<RG>(S, kb0, tq, hi, slope2, mfix);
                const unsigned tba = (unsigned)(size_t)tb + kbase;
#pragma unroll
                for (int hb = 0; hb < 2; ++hb) { bf16x8 kf[4];
                    lds_k4(kf, tba + 16u * ((unsigned)(8 * hb + 0 + hi) ^ kx), tba + 16u * ((unsigned)(8 * hb + 2 + hi) ^ kx), tba + 16u * ((unsigned)(8 * hb + 4 + hi) ^ kx), tba + 16u * ((unsigned)(8 * hb + 6 + hi) ^ kx));
#pragma unroll
                    for (int s = 0; s < 4; ++s) S = __builtin_amdgcn_mfma_f32_32x32x16_bf16(kf[s], qf[4 * hb + s], S, 0, 0, 0); }
                bf16x8 P[2];
                dil_softmax<RG>(S, kb0, tq, hi, lrun, P);
                dil_pv_asm(Oa, (unsigned)(size_t)tb + 8192u, va0, va1, P);
            }
        }
        asm volatile("s_waitcnt vmcnt(0)" ::: "memory");
        __syncthreads();
    }
#undef DIL_TDMA
}
__device__ __forceinline__ void dil_attn_phase(LAS unsigned char* lds_all, const bf16* Qd, const bf16* Kd, const bf16* Vd, bf16* O, const float* gq, const float* gk, int G, int c) {
    float mfix = 0.f;
    for (int g = 0; g < 3; ++g) { float mq = 0.f, mk = 0.f;
        for (int i = 0; i < 128; ++i) { mq = fmaxf(mq, fabsf(gq[g * 128 + i])); mk = fmaxf(mk, fabsf(gk[g * 128 + i])); }
        mfix = fmaxf(mfix, 1.03f * 11.313708499f * LOG2E * mq * mk); }
    mfix = __builtin_bit_cast(float, __builtin_amdgcn_readfirstlane(__builtin_bit_cast(int, mfix)));
    for (int it = 0;; ++it) {
        const int vc = (G % 8 == 0) ? (c % 8) * (G / 8) + c / 8 : c;
        const int u = it * G + vc; if (u >= 512) break;
        int tid_ = threadIdx.x; asm volatile("" : "+v"(tid_));
        const int tid = tid_, lane = tid & 63, w = __builtin_amdgcn_readfirstlane(tid >> 6), hi = lane >> 5, l32 = lane & 31;
        LAS unsigned char* ldsw = lds_all + w * 16384;
        unsigned va0, va1;
        { const unsigned blk = (lane >> 4) & 1, q4 = (lane & 15) >> 2, p = lane & 3;
          va0 = offb(8 * hi + q4, 2 * blk + (p >> 1)) + 8 * (p & 1); va1 = offb(8 * hi + 4 + q4, 2 * blk + (p >> 1)) + 8 * (p & 1); }
        const int kslot = pislot(l32);
        const unsigned kx = ((kslot & 3) << 2) | ((kslot >> 2) & 3), kbase = 256u * kslot;
        const int half = u & 1, ab = (u >> 1) & 15, bh = u >> 5, b = bh >> 3, h = bh & 7;
        const int cl = 2 * half + (w >> 2), rho = 4 * (w & 3) + cl;
        const size_t tok0 = (size_t)b * SEQ;
        const int tq0 = 512 * ab + rho, tq = tq0 + 16 * l32;
        const bf16* Vg = Vd + tok0 * DM + h * 256;
        f32x16 Oa[8];
#pragma unroll
        for (int cc = 0; cc < 8; ++cc)
#pragma unroll
            for (int r = 0; r < 16; ++r) Oa[cc][r] = 0.f;
        float lrun = 0.f;
        __syncthreads();
        {
            const float slope2 = __builtin_bit_cast(float, __builtin_amdgcn_readfirstlane(__builtin_bit_cast(int, __builtin_amdgcn_exp2f((float)(h + 1) * (-8.0f / 24.0f)) * LOG2E)));
            dil_shared_group<1, 20, 1, 2>(lds_all, Oa, lrun, Qd + (tok0 + tq) * 3072 + h * 128 + 8 * hi, Kd + tok0 * 3072 + h * 128, Vg, 32 * (16 * ab - 4), tq, w, lane, hi, kbase, kx, va0, va1, slope2, mfix);
        }
        {
            const float slope2 = __builtin_bit_cast(float, __builtin_amdgcn_readfirstlane(__builtin_bit_cast(int, __builtin_amdgcn_exp2f((float)(8 + h + 1) * (-8.0f / 24.0f)) * LOG2E)));
            dil_shared_group<4, 8, 2, 1>(lds_all, Oa, lrun, Qd + (tok0 + tq) * 3072 + (8 + h) * 128 + 8 * hi, Kd + tok0 * 3072 + (8 + h) * 128, Vg, 4 * 32 * (4 * ab - 4) + cl, tq, w, lane, hi, kbase, kx, va0, va1, slope2, mfix);
        }
        {
            constexpr int rg = 16;
            int t3 = threadIdx.x; asm volatile("" : "+v"(t3));
            const int lane3 = t3 & 63, hi = lane3 >> 5, l32 = lane3 & 31, kslot = pislot(l32), tq = tq0 + 16 * l32, drow = lane3 >> 4, dchp = lane3 & 15;
            unsigned va0, va1;
            { const unsigned blk = (lane3 >> 4) & 1, q4 = (lane3 & 15) >> 2, p = lane3 & 3;
              va0 = offb(8 * hi + q4, 2 * blk + (p >> 1)) + 8 * (p & 1); va1 = offb(8 * hi + 4 + q4, 2 * blk + (p >> 1)) + 8 * (p & 1); }
            const float slope2 = __builtin_bit_cast(float, __builtin_amdgcn_readfirstlane(__builtin_bit_cast(int, __builtin_amdgcn_exp2f((float)(16 + h + 1) * (-8.0f / 24.0f)) * LOG2E)));
            const bf16* Qp = Qd + (tok0 + tq) * 3072 + (16 + h) * 128 + 8 * hi;
            const bf16* Kg = Kd + tok0 * 3072 + (16 + h) * 128 + 8 * hi;
            const int tlo = tq0 - 128 * rg;
            bf16x8 qf[8];
#pragma unroll
            for (int s = 0; s < 8; ++s) qf[s] = *(const bf16x8*)(Qp + 16 * s);
#define DIL_VDMA(KB0) do { _Pragma("unroll") for (int i_ = 0; i_ < 16; ++i_) { const int row_ = 4 * (i_ & 7) + drow; const int tk_ = (KB0) + rg * row_; \
        const int ch_ = dchp ^ (((row_ & 3) << 2) | ((row_ >> 2) & 3)); \
        __builtin_amdgcn_global_load_lds((const unsigned*)(Vg + (long)tk_ * DM + (i_ >> 3) * 128 + ch_ * 8), (LAS unsigned*)(ldsw + i_ * 1024), 16, 0, 0); } } while (0)
#define DIL_KLOAD(KB0) do { const int tkk_ = (KB0) + rg * kslot; const bf16* Kp_ = Kg + (long)tkk_ * 3072; \
        _Pragma("unroll") for (int s_ = 0; s_ < 8; ++s_) kf[s_] = *(const bf16x8*)(Kp_ + 16 * s_); } while (0)
            int kb = 0;
            while (tlo + rg * (32 * kb + 31) < 0) ++kb;
#pragma unroll 1
            for (; kb < 5; ++kb) {
                const int kb0 = tlo + rg * 32 * kb;
                DIL_VDMA(kb0);
                f32x16 S;
                dil_cinit<rg>(S, kb0, tq, hi, slope2, mfix);
                { const bf16* Kp = Kg + (long)(kb0 + rg * kslot) * 3072;
                  bf16x8 kf[8];
#pragma unroll
                  for (int s = 0; s < 8; ++s) kf[s] = *(const bf16x8*)(Kp + 16 * s);
                  asm volatile("" ::: "memory");
#pragma unroll
                  for (int s = 0; s < 8; ++s) S = __builtin_amdgcn_mfma_f32_32x32x16_bf16(kf[s], qf[s], S, 0, 0, 0);
                  asm volatile("" ::: "memory"); }
                bf16x8 P[2];
                dil_softmax<rg>(S, kb0, tq, hi, lrun, P);
                asm volatile("s_waitcnt vmcnt(0)" ::: "memory");
                dil_pv(Oa, ldsw, va0, va1, P);
                asm volatile("s_waitcnt lgkmcnt(0)" ::: "memory");
            }
#undef DIL_VDMA
#undef DIL_KLOAD
        }
        lrun += __shfl_xor(lrun, 32);
        const float inv = 1.0f / lrun;
        int t2 = threadIdx.x; asm volatile("" : "+v"(t2));
        bf16* Op = O + (tok0 + tq0 + 16 * (t2 & 31)) * DM + h * 256 + 4 * ((t2 >> 5) & 1);
#pragma unroll
        for (int cc = 0; cc < 8; ++cc)
#pragma unroll
            for (int gg = 0; gg < 4; ++gg) { u32x2 wv; wv.x = cvtpk(Oa[cc][4 * gg] * inv, Oa[cc][4 * gg + 1] * inv); wv.y = cvtpk(Oa[cc][4 * gg + 2] * inv, Oa[cc][4 * gg + 3] * inv);
                *(u32x2*)(Op + 32 * cc + 8 * gg) = wv; }
    }
    __syncthreads();
}
#define XB_TMO      128
#define XB_XCNT(j)  (256  + 64 * (j))
#define XB_XSUB(j)  (1280 + 64 * (j))
#define XB_XGEN(j)  (2304 + 64 * (j))
#define XB_TOP      3328
#define XB_TOPGEN   3392
#define XCD_BAR_WORDS 3456
#define XB_SPIN_CAP (1u << 18)

__device__ __forceinline__ unsigned xb_ld(unsigned* p)              { return __hip_atomic_load(p, __ATOMIC_RELAXED, __HIP_MEMORY_SCOPE_AGENT); }
__device__ __forceinline__ unsigned xb_add(unsigned* p, unsigned v) { return __hip_atomic_fetch_add(p, v, __ATOMIC_RELAXED, __HIP_MEMORY_SCOPE_AGENT); }
__device__ __forceinline__ unsigned xb_xcc_id() { return (unsigned)__builtin_amdgcn_s_getreg((3 << 11) | 20) & 0xFu; }
#define XB_SPIN(cond, bar) do { unsigned _sp = 0; while (cond) { __builtin_amdgcn_s_sleep(1); \
    if ((++_sp & 255u) == 0u) { if (xb_ld(&(bar)[XB_TMO])) break; if (_sp > XB_SPIN_CAP) { atomicAdd(&(bar)[XB_TMO], 1u); break; } } } } while (0)

struct XcdBarrier {
    unsigned* bar; unsigned x;
    volatile LAS unsigned* st;
};

__device__ __forceinline__ XcdBarrier xcd_barrier_post(unsigned* bar, volatile LAS unsigned* st) {
    XcdBarrier b; b.bar = bar; b.x = xb_xcc_id(); b.st = st;
    if (threadIdx.x == 0) (void)xb_add(&bar[XB_XCNT(b.x)], 1u);
    return b;
}
__device__ __forceinline__ void xcd_barrier_complete(unsigned* bar, unsigned x, unsigned& nloc, unsigned& nx) {
    const unsigned G = gridDim.x * gridDim.y * gridDim.z;
    unsigned sum, cnt, mine, sp = 0u;
    for (;;) {
        sum = 0u; cnt = 0u; mine = 0u;
#pragma unroll
        for (unsigned j = 0; j < 16; ++j) { const unsigned c = xb_ld(&bar[XB_XCNT(j)]); sum += c; cnt += (c > 0u) ? 1u : 0u; mine = (j == x) ? c : mine; }
        if (sum == G) break;
        __builtin_amdgcn_s_sleep(1);
        if ((++sp & 255u) == 0u) { if (xb_ld(&bar[XB_TMO])) break; if (sp > XB_SPIN_CAP) { atomicAdd(&bar[XB_TMO], 1u); break; } }
    }
    nloc = mine > 0u ? mine : 1u; nx = cnt > 0u ? cnt : 1u;
}

__device__ __forceinline__ void xcd_barrier(const XcdBarrier& b) {
    asm volatile("s_waitcnt vmcnt(0)" ::: "memory");
    __syncthreads();
    if (threadIdx.x == 0) {
        unsigned* bar = b.bar;
        __builtin_amdgcn_s_waitcnt(0);
        unsigned nloc = b.st[0], nx = b.st[1];
        if (nloc == 0u) { xcd_barrier_complete(bar, b.x, nloc, nx); b.st[0] = nloc; b.st[1] = nx; }
        const unsigned old = xb_add(&bar[XB_XSUB(b.x)], 1u);
        const unsigned gen = old / nloc;
        if (old + 1u == (gen + 1u) * nloc) {
            __builtin_amdgcn_fence(__ATOMIC_RELEASE, "agent");
            asm volatile("s_waitcnt vmcnt(0)" ::: "memory");
            const unsigned og = xb_add(&bar[XB_TOP], 1u);
            const unsigned tg = og / nx;
            if (og + 1u == (tg + 1u) * nx) xb_add(&bar[XB_TOPGEN], 1u);
            else XB_SPIN(xb_ld(&bar[XB_TOPGEN]) == tg, bar);
            __builtin_amdgcn_fence(__ATOMIC_ACQUIRE, "agent");
            xb_add(&bar[XB_XGEN(b.x)], 1u);
            asm volatile("s_waitcnt vmcnt(0)" ::: "memory");
        } else {
            XB_SPIN(xb_ld(&bar[XB_XGEN(b.x)]) == gen, bar);
            __builtin_amdgcn_fence(__ATOMIC_ACQUIRE, "agent");
            asm volatile("s_waitcnt vmcnt(0)" ::: "memory");
        }
    }
    __syncthreads();
}
constexpr size_t MiB = 1u << 20;
constexpr size_t WS_BAR = 768 * 1024;
constexpr size_t WS_SSP = 0, WS_LF = 1 * MiB, WS_D2 = 2 * MiB, WS_WF = 3 * MiB;
constexpr size_t WS_FOX_IN = 4 * MiB, WS_FOX_O = 28 * MiB, WS_DIL_IN = 36 * MiB, WS_DIL_O = 68 * MiB, WS_UP0 = 76 * MiB, WS_UP1 = 108 * MiB, WS_DN0 = 140 * MiB, WS_DN1 = 172 * MiB;
constexpr size_t WS_XB = 204 * MiB, WS_R = 268 * MiB, WS_END = 524 * MiB;
constexpr int RING_BYTES = 131072, EX_OFF = RING_BYTES, LDS_BYTES = 147456;
constexpr int NWAVES = 8;
#define REP_P0 1
#define REP_FOX 1
#define REP_DIL 1
#define LDS_WAIT() asm volatile("s_waitcnt lgkmcnt(0)" ::: "memory")
__device__ __forceinline__ unsigned f2bf(float f) { unsigned u = __builtin_bit_cast(unsigned, f); return (u + 0x7fffu + ((u >> 16) & 1u)) >> 16; }
__device__ __forceinline__ unsigned pk2(float lo, float hi) { return f2bf(lo) | (f2bf(hi) << 16); }
__device__ __forceinline__ float wave_sum(float v) {
#pragma unroll
    for (int o = 1; o < 64; o <<= 1) v += __shfl_xor(v, o);
    return v;
}
__device__ __forceinline__ void tr_load(f32x4 (&v)[16], const float* W, int ld, int col0, int ncv, int item, int nblk, int lane) {
    const int kb = item / nblk, nb = item % nblk, k0 = 64 * kb, n0 = 64 * nb; const int n4 = (lane & 15) * 4; const bool okc = (n0 + n4) < ncv;
#pragma unroll
    for (int i = 0; i < 16; ++i) { const int kk = 4 * i + (lane >> 4); v[i] = okc ? *(const f32x4*)(W + (size_t)(k0 + kk) * ld + col0 + n0 + n4) : (f32x4){0.f, 0.f, 0.f, 0.f}; }
}
__device__ __forceinline__ void tr_store(const f32x4 (&v)[16], int ncv, int K, const float* g, bf16* WT, LAS float* scr, int item, int nblk, int lane) {
    const int kb = item / nblk, nb = item % nblk, k0 = 64 * kb, n0 = 64 * nb; const int n4 = (lane & 15) * 4;
#pragma unroll
    for (int i = 0; i < 16; ++i) { const int kk = 4 * i + (lane >> 4); f32x4 t = v[i]; if (g) t = t * g[k0 + kk]; LAS float* d = scr + kk * 65 + n4; d[0] = t[0]; d[1] = t[1]; d[2] = t[2]; d[3] = t[3]; }
    LDS_WAIT(); asm volatile("" ::: "memory");
    const int cch = lane & 7;
#pragma unroll
    for (int j = 0; j < 8; ++j) { const int n = (lane >> 3) + 8 * j; const LAS float* s = scr + (8 * cch) * 65 + n;
        u32x4 o; o.x = pk2(s[0 * 65], s[1 * 65]); o.y = pk2(s[2 * 65], s[3 * 65]); o.z = pk2(s[4 * 65], s[5 * 65]); o.w = pk2(s[6 * 65], s[7 * 65]);
        if (n0 + n < ncv) *(u32x4*)(WT + (size_t)(n0 + n) * K + k0 + 8 * cch) = o; }
    LDS_WAIT(); asm volatile("" ::: "memory");
}
struct Args { const float* in[14]; float* out; unsigned char* ws; };
struct Mat { const float* W; int ld, col0, ncv, K; const float* g; size_t wt; };

__global__ void __launch_bounds__(NWAVES * 64, 2) fwd_megakernel(Args args) {
    extern __shared__ __attribute__((aligned(16))) unsigned char lds_raw[];
    LAS unsigned char* lds = (LAS unsigned char*)lds_raw;
    cg::grid_group grid = cg::this_grid();
    const int tid = threadIdx.x, lane = tid & 63, wave = __builtin_amdgcn_readfirstlane(tid >> 6);
    const int G = gridDim.x, c = blockIdx.x;
    unsigned char* ws = args.ws;
    volatile LAS unsigned* bst = (volatile LAS unsigned*)(lds + LDS_BYTES - 64);
    if (tid < 16) bst[tid] = 0u;
    __syncthreads();
    (void)xcd_barrier_post((unsigned*)(ws + WS_BAR), bst);
#define GRID_BAR() do { XcdBarrier b_; b_.bar = (unsigned*)(args.ws + WS_BAR); b_.x = xb_xcc_id(); b_.st = (volatile LAS unsigned*)(lds + LDS_BYTES - 64); xcd_barrier(b_); } while (0)
    const float* x = args.in[0];
    float* out = args.out;
    float* SSP = (float*)(ws + WS_SSP); float* LF = (float*)(ws + WS_LF); float* D2 = (float*)(ws + WS_D2); bf16* WfT = (bf16*)(ws + WS_WF);
    bf16* XB = (bf16*)(ws + WS_XB);
    const int gw = c * NWAVES + wave, NGW = G * NWAVES;

#pragma unroll 1
    for (int rep0 = 0; rep0 < REP_P0; ++rep0)
    {
        LAS float* scr = (LAS float*)(lds + wave * 16640);
        const float* mixg = args.in[10]; const float* mlpg = args.in[11];
#pragma unroll 1
        for (int mi = 0; mi < 9; ++mi) {
            Mat M;
            switch (mi) {
                case 0: M = Mat{args.in[1], 6160, 0, 6144, 2048, mixg, WS_FOX_IN}; break;
                case 1: M = Mat{args.in[1], 6160, 6144, 16, 2048, mixg, WS_WF}; break;
                case 2: M = Mat{args.in[5], 2048, 0, 2048, 2048, nullptr, WS_FOX_O}; break;
                case 3: M = Mat{args.in[6], 8192, 0, 8192, 2048, mixg + 2048, WS_DIL_IN}; break;
                case 4: M = Mat{args.in[9], 2048, 0, 2048, 2048, nullptr, WS_DIL_O}; break;
                case 5: M = Mat{args.in[12], 8192, 0, 8192, 2048, mlpg, WS_UP0}; break;
                case 6: M = Mat{args.in[12] + (size_t)2048 * 8192, 8192, 0, 8192, 2048, mlpg + 2048, WS_UP1}; break;
                case 7: M = Mat{args.in[13], 2048, 0, 2048, 8192, nullptr, WS_DN0}; break;
                default: M = Mat{args.in[13] + (size_t)8192 * 2048, 2048, 0, 2048, 8192, nullptr, WS_DN1}; break;
            }
            const int nblk = (M.ncv + 63) / 64, nitems = (M.K / 64) * nblk;
            if (gw < nitems) {
                f32x4 va[16], vb[16];
                tr_load(va, M.W, M.ld, M.col0, M.ncv, gw, nblk, lane);
                for (int itx = gw; itx < nitems; itx += 2 * NGW) {
                    if (itx + NGW < nitems) tr_load(vb, M.W, M.ld, M.col0, M.ncv, itx + NGW, nblk, lane);
                    tr_store(va, M.ncv, M.K, M.g, (bf16*)(ws + M.wt), scr, itx, nblk, lane);
                    if (itx + NGW < nitems) {
                        if (itx + 2 * NGW < nitems) tr_load(va, M.W, M.ld, M.col0, M.ncv, itx + 2 * NGW, nblk, lane);
                        tr_store(vb, M.ncv, M.K, M.g, (bf16*)(ws + M.wt), scr, itx + NGW, nblk, lane);
                    }
                }
            }
        }
        {
            f32x4 v[8], vn[8];
#pragma unroll
            for (int j = 0; j < 8; ++j) v[j] = ((const f32x4*)(x + (size_t)gw * DM) + lane)[64 * j];
            for (int m = gw; m < NTOK; m += NGW) {
                if (m + NGW < NTOK) {
#pragma unroll
                    for (int j = 0; j < 8; ++j) vn[j] = ((const f32x4*)(x + (size_t)(m + NGW) * DM) + lane)[64 * j]; }
                float s = 0.f;
#pragma unroll
                for (int j = 0; j < 8; ++j) s += (v[j][0] * v[j][0] + v[j][1] * v[j][1]) + (v[j][2] * v[j][2] + v[j][3] * v[j][3]);
                s = wave_sum(s);
                if (lane < 8) SSP[(size_t)lane * NTOK + m] = lane == 0 ? s : 0.f;
                u32x2* o8 = (u32x2*)(XB + (size_t)m * DM) + lane;
#pragma unroll
                for (int j = 0; j < 8; ++j) { u32x2 wv; wv.x = pk2(v[j][0], v[j][1]); wv.y = pk2(v[j][2], v[j][3]); o8[64 * j] = wv; }
#pragma unroll
                for (int j = 0; j < 8; ++j) v[j] = vn[j];
            }
        }
    }
    if (args.out == nullptr) grid.sync();
    GRID_BAR();

    bf16* R = (bf16*)(ws + WS_R);
    LAS unsigned char* ex = lds + EX_OFF;
    {
        bf16* Qf = R; bf16* Kf = R + (size_t)NTOK * DM; bf16* Vf = R + (size_t)2 * NTOK * DM; bf16* Of = R + (size_t)3 * NTOK * DM;
        { pg8::Gemm g{XB, (const bf16*)(ws + WS_FOX_IN), NTOK, 6144, 2048}; pg8::StaticOrder S; S.init(NTOK, 6144, G, c);
          pg8::EpiQKV E{Qf, Kf, Vf, 8, 2048, args.in[3], args.in[4], 1 << 20, SSP, ex};
          pg8::epi_rs_invalidate(ex); pg8::gemm_phase<pg8::EpiQKV, pg8::StaticOrder, true, true>(lds, g, S, E); }
        int tf_ = threadIdx.x; asm volatile("" : "+v"(tf_));
        for (int task = c * NWAVES + (tf_ >> 6); task < NTOK / 16; task += NGW) {
            const int lane = tf_ & 63, i16 = lane & 15, kq = lane >> 4, tok = 16 * task + i16;
            const bf16* ap = WfT + (size_t)i16 * DM + 8 * kq; const bf16* bp = XB + (size_t)tok * DM + 8 * kq;
            f32x4 acc = {0.f, 0.f, 0.f, 0.f};
#pragma unroll 1
            for (int s0 = 0; s0 < 64; s0 += 16) {
                bf16x8 fa[16], fb[16];
#pragma unroll
                for (int s = 0; s < 16; ++s) { fa[s] = *(const bf16x8*)(ap + 32 * (s0 + s)); fb[s] = *(const bf16x8*)(bp + 32 * (s0 + s)); }
#pragma unroll
                for (int s = 0; s < 16; ++s) acc = __builtin_amdgcn_mfma_f32_16x16x32_bf16(fa[s], fb[s], acc, 0, 0, 0);
            }
            float ss = 0.f;
#pragma unroll
            for (int i = 0; i < 8; ++i) ss += SSP[(size_t)i * NTOK + tok];
            const float rs = rsqrtf(ss * (1.0f / 2048.0f) + 1e-6f);
#pragma unroll
            for (int r = 0; r < 4; ++r) { const int hh = 4 * kq + r; const float z = acc[r] * rs + args.in[2][hh];
                LF[(size_t)hh * NTOK + tok] = fminf(z, 0.f) - log1pf(__expf(-fabsf(z))); }
        }
        GRID_BAR();
        if (c < 32) {
            int tc_ = threadIdx.x; asm volatile("" : "+v"(tc_)); const int tid = tc_, lane = tc_ & 63, wave = tc_ >> 6;
            const int b = c >> 4, h = c & 15; const float* src = LF + (size_t)h * NTOK + (size_t)b * SEQ + 16 * tid; float* dst = D2 + (size_t)c * SEQ + 16 * tid;
            f32x4 v[4]; float run = 0.f;
#pragma unroll
            for (int j = 0; j < 4; ++j) { v[j] = *(const f32x4*)(src + 4 * j);
#pragma unroll
                for (int e = 0; e < 4; ++e) { run += v[j][e]; v[j][e] = run; } }
            float incl = run;
#pragma unroll
            for (int o = 1; o < 64; o <<= 1) { const float t = __shfl_up(incl, o); if (lane >= o) incl += t; }
            LAS float* wt = (LAS float*)lds;
            if (lane == 63) wt[wave] = incl;
            __syncthreads();
            float pre = incl - run;
            for (int ww = 0; ww < wave; ++ww) pre += wt[ww];
#pragma unroll
            for (int j = 0; j < 4; ++j) { f32x4 o;
#pragma unroll
                for (int e = 0; e < 4; ++e) o[e] = -(v[j][e] + pre) * LOG2E;
                *(f32x4*)(dst + 4 * j) = o; }
        }
        GRID_BAR();
        for (int rep = 0; rep < REP_FOX; ++rep) fox_attn_phase(lds, Qf, Of, Kf, Vf, D2, args.in[3], args.in[4], G, c);
        GRID_BAR();
        { pg8::Gemm g{Of, (const bf16*)(ws + WS_FOX_O), NTOK, 2048, 2048}; pg8::StaticOrder S; S.init(NTOK, 2048, G, c);
          pg8::EpiRes E{XB, nullptr, XB, SSP, ex};
          pg8::gemm_phase<pg8::EpiRes, pg8::StaticOrder, true, true>(lds, g, S, E); }
        GRID_BAR();
    }
#define MLP_BLOCK(UPW, DNW, FINAL) do { \
            { pg8::Gemm g{XB, (const bf16*)(ws + (UPW)), NTOK, 8192, 2048}; pg8::StaticOrder S; S.init(NTOK, 8192, G, c); \
              pg8::EpiUp E{R, SSP, ex}; pg8::epi_rs_invalidate(ex); pg8::gemm_phase<pg8::EpiUp, pg8::StaticOrder, true, true>(lds, g, S, E); } \
            GRID_BAR(); \
            { pg8::Gemm g{R, (const bf16*)(ws + (DNW)), NTOK, 2048, 8192}; pg8::StaticOrder S; S.init(NTOK, 2048, G, c); \
              pg8::EpiRes E{XB, (FINAL) ? out : nullptr, (FINAL) ? nullptr : XB, SSP, ex}; pg8::gemm_phase<pg8::EpiRes, pg8::StaticOrder, true, true>(lds, g, S, E); } \
            if (!(FINAL)) GRID_BAR(); } while (0)
    MLP_BLOCK(WS_UP0, WS_DN0, false);
    {
        bf16* Qd = R; bf16* Kd = R + (size_t)NTOK * 3072; bf16* Vd = R + (size_t)2 * NTOK * 3072; bf16* Od = (bf16*)out;
        { pg8::Gemm g{XB, (const bf16*)(ws + WS_DIL_IN), NTOK, 8192, 2048}; pg8::StaticOrder S; S.init(NTOK, 8192, G, c);
          pg8::EpiQKV E{Qd, Kd, Vd, 12, 3072, args.in[7], args.in[8], 4, SSP, ex};
          pg8::epi_rs_invalidate(ex); pg8::gemm_phase<pg8::EpiQKV, pg8::StaticOrder, true, true>(lds, g, S, E); }
        GRID_BAR();
        for (int rep = 0; rep < REP_DIL; ++rep) dil_attn_phase(lds, Qd, Kd, Vd, Od, args.in[7], args.in[8], G, c);
        GRID_BAR();
        { pg8::Gemm g{Od, (const bf16*)(ws + WS_DIL_O), NTOK, 2048, 2048}; pg8::StaticOrder S; S.init(NTOK, 2048, G, c);
          pg8::EpiRes E{XB, nullptr, XB, SSP, ex};
          pg8::gemm_phase<pg8::EpiRes, pg8::StaticOrder, true, true>(lds, g, S, E); }
        GRID_BAR();
        MLP_BLOCK(WS_UP1, WS_DN1, true);
    }
}

extern "C" void kernel_launch(void* const* d_in, const int* in_sizes, int n_in, void* d_out, int out_size, void* d_ws, size_t ws_size, hipStream_t stream) {
    static int grid = 0;
    if (grid == 0) {
        if (n_in != 14 || ws_size < WS_END) { fprintf(stderr, "kernel_launch: need 14 inputs and >= %zu bytes of workspace (got %d, %zu)\n", (size_t)WS_END, n_in, ws_size); grid = -1; return; }
        int dev = 0, cus = 0, per_cu = 0;
        hipGetDevice(&dev); hipDeviceGetAttribute(&cus, hipDeviceAttributeMultiprocessorCount, dev);
        if (hipFuncSetAttribute((const void*)fwd_megakernel, hipFuncAttributeMaxDynamicSharedMemorySize, LDS_BYTES) != hipSuccess) { fprintf(stderr, "kernel_launch: hipFuncSetAttribute failed\n"); grid = -1; return; }
        if (hipOccupancyMaxActiveBlocksPerMultiprocessor(&per_cu, (const void*)fwd_megakernel, NWAVES * 64, LDS_BYTES) != hipSuccess || per_cu < 1) { fprintf(stderr, "kernel_launch: occupancy query gave %d\n", per_cu); per_cu = 1; }
        (void)hipGetLastError();
        grid = cus * 1;
    }
    if (grid < 0) return;
    if (hipMemsetAsync((char*)d_ws + WS_BAR, 0, 16384, stream) != hipSuccess) { fprintf(stderr, "kernel_launch: memset of the barrier words failed\n"); return; }
    Args a{};
    for (int i = 0; i < 14; ++i) a.in[i] = (const float*)d_in[i];
    a.out = (float*)d_out; a.ws = (unsigned char*)d_ws;
    void* kargs[] = {&a};
    hipError_t e = hipLaunchCooperativeKernel((const void*)fwd_megakernel, dim3(grid), dim3(NWAVES * 64), kargs, LDS_BYTES, stream);
    if (e != hipSuccess) fprintf(stderr, "kernel_launch: cooperative launch failed: %s (grid %d)\n", hipGetErrorString(e), grid);
}
```

```cpp
#include <hip/hip_runtime.h>
#include <hip/hip_cooperative_groups.h>
#include <cstdio>
#include <cstdint>
#include <cmath>
namespace cg = cooperative_groups;
namespace pg8 {
#define PG8_LAS __attribute__((address_space(3)))
typedef unsigned short bf16_t;
typedef short bf16x8 __attribute__((ext_vector_type(8)));
typedef float f32x4 __attribute__((ext_vector_type(4)));
typedef unsigned u32x4 __attribute__((ext_vector_type(4)));
constexpr int BM = 256, BK = 64, HALF = 128, HTB = HALF * BK * 2  , STAGE_BYTES = 8 * HTB, NXCD = 8, WGM = 8;

__host__ __device__ __forceinline__ int lds_byte(int r, int c) { const int st = (r >> 4) * 2 + (c >> 5), rr = r & 15, cc = c & 31, ob = rr * 64 + cc * 2; return st * 1024 + (ob ^ (((ob >> 9) & 1) << 5)); }
__host__ __device__ __forceinline__ void stage_rc(int b, int& R, int& C) { const int st = b / 1024, sb = b % 1024, swz = sb ^ (((sb >> 9) & 1) << 5); R = (st >> 1) * 16 + swz / 64; C = (st & 1) * 32 + (swz % 64) / 2; }
__host__ __device__ __forceinline__ int perm32(int rho) { const int n = rho >> 4, i = rho & 15; return 8 * (i >> 2) + 4 * n + (i & 3); }

struct Unit { int pm, pn; };
struct Gemm { const bf16_t* A; const bf16_t* Bt; int M, N, K; };

struct StaticOrder {
    int nM, nN, nwg, G, c;
    __host__ __device__ void init(int M, int N, int G_, int c_) { nM = M / BM; nN = N / BM; nwg = nM * nN; G = G_; c = c_; }
    __host__ __device__ bool next(int i, Unit& u) const {
        const long L = (long)i * G + c; if (L >= nwg) return false;
        int wgid = (int)L; { const int q = nwg / NXCD, r = nwg % NXCD, xcd = wgid % NXCD, off = wgid / NXCD; wgid = (xcd < r ? xcd * (q + 1) : r * (q + 1) + (xcd - r) * q) + off; }
        const int nig = WGM * nN, gid = wgid / nig, fm = gid * WGM, gsz = (nM - fm) < WGM ? (nM - fm) : WGM;
        u.pm = fm + ((wgid % nig) % gsz); u.pn = (wgid % nig) / gsz; return true;
    }
    __device__ __forceinline__ void a_ready(const Unit&) const {}
    __device__ __forceinline__ void done(const Unit&) const {}
};

__device__ __forceinline__ unsigned cvt_pk_bf16(float lo, float hi) { unsigned r; asm volatile("v_cvt_pk_bf16_f32 %0, %1, %2" : "=v"(r) : "v"(lo), "v"(hi)); return r; }
typedef float f32x2 __attribute__((ext_vector_type(2)));
constexpr int TOK = 16384;
__device__ __forceinline__ float sq4(f32x4 v) { return (v[0] * v[0] + v[1] * v[1]) + (v[2] * v[2] + v[3] * v[3]); }
__device__ __forceinline__ bool epi_rs_table(PG8_LAS float* RS, PG8_LAS unsigned char* ex, const float* ssp, int pm) {
    const int tid = threadIdx.x;
    if (*(volatile PG8_LAS int*)(ex + 12288) == pm) return false;
    if (tid < 256) { float s = 0.f;
#pragma unroll
        for (int i = 0; i < 8; ++i) s += ssp[(size_t)i * TOK + pm * BM + tid];
        RS[tid] = rsqrtf(s * (1.0f / 2048.0f) + 1e-6f); }
    return true;
}
__device__ __forceinline__ void epi_rs_commit(PG8_LAS unsigned char* ex, int pm) { if (threadIdx.x == 0) *(volatile PG8_LAS int*)(ex + 12288) = pm; }
__device__ __forceinline__ void epi_rs_invalidate(PG8_LAS unsigned char* ex) { if (threadIdx.x == 0) *(volatile PG8_LAS int*)(ex + 12288) = -1; }
#define EPI_SYNC() do { asm volatile("s_waitcnt lgkmcnt(0)" ::: "memory"); __builtin_amdgcn_s_barrier(); asm volatile("" ::: "memory"); } while (0)

struct EpiQKV {
    static constexpr bool PERM = true, AFTER_DRAIN = false;
    bf16_t *Q, *Kb, *V; int nq, pitch_qk; const float *gq, *gk; int gain_tiles; const float* ssp; PG8_LAS unsigned char* ex;
    __device__ __forceinline__ void operator()(const f32x4 (&acc)[2][2][4][2], const Unit& u, int wr, int wc, int fr, int fq) const {
        PG8_LAS float* RS = (PG8_LAS float*)ex; PG8_LAS float* P = (PG8_LAS float*)(ex + 1024);
        const bool fresh = epi_rs_table(RS, ex, ssp, u.pm);
        const bool isV = u.pn >= 2 * nq;
        if (!isV) {
#pragma unroll
            for (int ai = 0; ai < 2; ++ai)
#pragma unroll
                for (int m = 0; m < 4; ++m)
#pragma unroll
                    for (int bj = 0; bj < 2; ++bj) { float q = sq4(acc[ai][bj][m][0]) + sq4(acc[ai][bj][m][1]); q += __shfl_xor(q, 16); q += __shfl_xor(q, 32);
                        if (fq == 0) P[((ai * HALF + wr * 64 + m * 16 + fr) * 2 + bj) * 4 + wc] = q; }
        }
        if (fresh || !isV) EPI_SYNC();
        if (fresh) epi_rs_commit(ex, u.pm);
        const int d0 = wc * 32 + 8 * fq;
        if (isV) {
            const int colt = (u.pn - 2 * nq) * BM + d0;
#pragma unroll
            for (int ai = 0; ai < 2; ++ai)
#pragma unroll
                for (int m = 0; m < 4; ++m) { const int rl = ai * HALF + wr * 64 + m * 16 + fr; const float rs = RS[rl]; bf16_t* rowp = V + (size_t)(u.pm * BM + rl) * 2048 + colt;
#pragma unroll
                    for (int bj = 0; bj < 2; ++bj) { const f32x4 v0 = acc[ai][bj][m][0] * rs, v1 = acc[ai][bj][m][1] * rs; u32x4 w;
                        w.x = cvt_pk_bf16(v0[0], v0[1]); w.y = cvt_pk_bf16(v0[2], v0[3]); w.z = cvt_pk_bf16(v1[0], v1[1]); w.w = cvt_pk_bf16(v1[2], v1[3]); *(u32x4*)(rowp + bj * HALF) = w; } }
        } else {
            const bool isQ = u.pn < nq; const int tp = isQ ? u.pn : u.pn - nq; const float* gp = (isQ ? gq : gk) + (tp / gain_tiles) * 128 + d0;
            const float qs = isQ ? 0.08838834764831845f * 1.4426950408889634f : 1.0f;
            const f32x4 g0 = *(const f32x4*)gp * qs, g1 = *(const f32x4*)(gp + 4) * qs;
            bf16_t* base = (isQ ? Q : Kb) + tp * BM + d0;
#pragma unroll
            for (int ai = 0; ai < 2; ++ai)
#pragma unroll
                for (int m = 0; m < 4; ++m) { const int rl = ai * HALF + wr * 64 + m * 16 + fr; const float rs = RS[rl]; bf16_t* rowp = base + (size_t)(u.pm * BM + rl) * pitch_qk;
#pragma unroll
                    for (int bj = 0; bj < 2; ++bj) { const f32x4 pp = *(const PG8_LAS f32x4*)(P + (rl * 2 + bj) * 4); const float tot = (pp[0] + pp[1]) + (pp[2] + pp[3]);
                        const float f = rs * rsqrtf(rs * rs * tot * (1.0f / 128.0f) + 1e-6f);
                        const f32x4 v0 = acc[ai][bj][m][0] * f * g0, v1 = acc[ai][bj][m][1] * f * g1; u32x4 w;
                        w.x = cvt_pk_bf16(v0[0], v0[1]); w.y = cvt_pk_bf16(v0[2], v0[3]); w.z = cvt_pk_bf16(v1[0], v1[1]); w.w = cvt_pk_bf16(v1[2], v1[3]); *(u32x4*)(rowp + bj * HALF) = w; } }
        }
    }
};
struct EpiUp {
    static constexpr bool PERM = true, AFTER_DRAIN = false;
    bf16_t* H; const float* ssp; PG8_LAS unsigned char* ex;
    __device__ __forceinline__ void operator()(const f32x4 (&acc)[2][2][4][2], const Unit& u, int wr, int wc, int fr, int fq) const {
        PG8_LAS float* RS = (PG8_LAS float*)ex;
        if (epi_rs_table(RS, ex, ssp, u.pm)) { EPI_SYNC(); epi_rs_commit(ex, u.pm); }
        const int col0 = u.pn * BM + wc * 32 + 8 * fq;
#pragma unroll
        for (int ai = 0; ai < 2; ++ai)
#pragma unroll
            for (int m = 0; m < 4; ++m) { const int rl = ai * HALF + wr * 64 + m * 16 + fr; const float rs = RS[rl]; bf16_t* rowp = H + (size_t)(u.pm * BM + rl) * 8192 + col0;
#pragma unroll
                for (int bj = 0; bj < 2; ++bj) { f32x4 v0 = acc[ai][bj][m][0] * rs, v1 = acc[ai][bj][m][1] * rs;
#pragma unroll
                    for (int j = 0; j < 4; ++j) { v0[j] = fmaxf(v0[j], 0.f); v1[j] = fmaxf(v1[j], 0.f); }
                    v0 = v0 * v0; v1 = v1 * v1; u32x4 w;
                    w.x = cvt_pk_bf16(v0[0], v0[1]); w.y = cvt_pk_bf16(v0[2], v0[3]); w.z = cvt_pk_bf16(v1[0], v1[1]); w.w = cvt_pk_bf16(v1[2], v1[3]); *(u32x4*)(rowp + bj * HALF) = w; } }
    }
};
struct EpiRes {
    static constexpr bool PERM = true, AFTER_DRAIN = false;
    const bf16_t* base; float* out; bf16_t* xb; float* ssp; PG8_LAS unsigned char* ex;
    __device__ __forceinline__ void operator()(const f32x4 (&acc)[2][2][4][2], const Unit& u, int wr, int wc, int fr, int fq) const {
        PG8_LAS float* P = (PG8_LAS float*)(ex + 1024);
        const int col0 = u.pn * BM + wc * 32 + 8 * fq;
#pragma unroll
        for (int ai = 0; ai < 2; ++ai)
#pragma unroll
            for (int m = 0; m < 4; ++m) { const int rl = ai * HALF + wr * 64 + m * 16 + fr; const size_t off = (size_t)(u.pm * BM + rl) * 2048 + col0; float q = 0.f;
#pragma unroll
                for (int bj = 0; bj < 2; ++bj) { const u32x4 bw = *(const u32x4*)(base + off + bj * HALF);
                    f32x4 v0, v1;
                    v0[0] = __builtin_bit_cast(float, bw.x << 16); v0[1] = __builtin_bit_cast(float, bw.x & 0xffff0000u); v0[2] = __builtin_bit_cast(float, bw.y << 16); v0[3] = __builtin_bit_cast(float, bw.y & 0xffff0000u);
                    v1[0] = __builtin_bit_cast(float, bw.z << 16); v1[1] = __builtin_bit_cast(float, bw.z & 0xffff0000u); v1[2] = __builtin_bit_cast(float, bw.w << 16); v1[3] = __builtin_bit_cast(float, bw.w & 0xffff0000u);
                    v0 = v0 + acc[ai][bj][m][0]; v1 = v1 + acc[ai][bj][m][1];
                    if (out) { *(f32x4*)(out + off + bj * HALF) = v0; *(f32x4*)(out + off + bj * HALF + 4) = v1; }
                    q += sq4(v0) + sq4(v1);
                    if (xb) { u32x4 w; w.x = cvt_pk_bf16(v0[0], v0[1]); w.y = cvt_pk_bf16(v0[2], v0[3]); w.z = cvt_pk_bf16(v1[0], v1[1]); w.w = cvt_pk_bf16(v1[2], v1[3]); *(u32x4*)(xb + off + bj * HALF) = w; } }
                q += __shfl_xor(q, 16); q += __shfl_xor(q, 32);
                if (fq == 0) P[rl * 4 + wc] = q; }
        EPI_SYNC();
        const int tid = threadIdx.x;
        if (tid < 256) { const f32x4 pp = *(const PG8_LAS f32x4*)(P + tid * 4); ssp[(size_t)u.pn * TOK + u.pm * BM + tid] = (pp[0] + pp[1]) + (pp[2] + pp[3]); }
    }
};

template <class Epi, class Sched, bool ALIGN_EPI = false, bool SP2 = false>
__device__ __forceinline__ void gemm_phase(PG8_LAS unsigned char* lds, const Gemm g, const Sched& S, const Epi& E) {
    int tid_ = threadIdx.x; asm volatile("" : "+v"(tid_));
    const int tid = tid_, wid = __builtin_amdgcn_readfirstlane(tid >> 6), lane = tid & 63, wr = wid >> 2, wc = wid & 3, fr = lane & 15, fq = lane >> 4;
    const int K = g.K, nt = K / BK;
    unsigned voffA[2], voffB[2];
#pragma unroll
    for (int i = 0; i < 2; ++i) { int R, C; stage_rc(tid * 16 + i * 8192, R, C); const int Rb = Epi::PERM ? ((R & ~31) + perm32(R & 31)) : R;
        voffA[i] = (unsigned)(R * K + C) * 2u; voffB[i] = (unsigned)(Rb * K + C) * 2u; }
    const size_t kstep = (size_t)(BK * 2);
    const size_t hstep = (size_t)HALF * K * 2;
    const size_t tstep = 2 * hstep;
    const unsigned ldsw = (unsigned)wid * 1024u;
    const int aoff = lds_byte(wr * 64 + fr, fq * 8), boff = lds_byte(wc * 32 + fr, fq * 8);
#define PG8_SA(b, h) (((b) * 2 + (h)) * HTB)
#define PG8_SB(b, h) ((4 + (b) * 2 + (h)) * HTB)
#define PG8_STAGE(bufoff, gbase, voff) do { _Pragma("unroll") for (int _i = 0; _i < 2; ++_i) \
        __builtin_amdgcn_global_load_lds((const unsigned*)((const char*)(gbase) + (voff)[_i]), (PG8_LAS unsigned*)(lds + (bufoff) + ldsw + _i * 8192), 16, 0, 0); } while (0)
#define PG8_LDA(dst, b, h) do { _Pragma("unroll") for (int m = 0; m < 4; ++m) _Pragma("unroll") for (int k = 0; k < 2; ++k) dst[m][k] = *(const PG8_LAS bf16x8*)(lds + PG8_SA(b, h) + aoff + m * 2048 + k * 1024); } while (0)
#define PG8_LDB(dst, b, h) do { _Pragma("unroll") for (int n = 0; n < 2; ++n) _Pragma("unroll") for (int k = 0; k < 2; ++k) dst[n][k] = *(const PG8_LAS bf16x8*)(lds + PG8_SB(b, h) + boff + n * 2048 + k * 1024); } while (0)
#define PG8_MMA(ai, bj, At, Bt) do { __builtin_amdgcn_s_setprio(1); _Pragma("unroll") for (int m = 0; m < 4; ++m) _Pragma("unroll") for (int n = 0; n < 2; ++n) _Pragma("unroll") for (int k = 0; k < 2; ++k) \
        acc[ai][bj][m][n] = __builtin_amdgcn_mfma_f32_16x16x32_bf16(Bt[n][k], At[m][k], acc[ai][bj][m][n], 0, 0, 0); __builtin_amdgcn_s_setprio(0); } while (0)
#define PG8_WAIT_V(n) asm volatile("s_waitcnt vmcnt(" #n ")" ::: "memory")
#define PG8_WAIT_L(n) asm volatile("s_waitcnt lgkmcnt(" #n ")" ::: "memory")
#define PG8_BAR __builtin_amdgcn_s_barrier()
#define PG8_SCHED __builtin_amdgcn_sched_barrier(0)
    Unit cur, nxt; int ui = 0;
    if (!S.next(0, cur)) return;
    f32x4 acc[2][2][4][2];
#pragma unroll
    for (int a = 0; a < 2; ++a)
#pragma unroll
        for (int b = 0; b < 2; ++b)
#pragma unroll
            for (int m = 0; m < 4; ++m)
#pragma unroll
                for (int n = 0; n < 2; ++n) acc[a][b][m][n] = (f32x4){0.f, 0.f, 0.f, 0.f};
    bf16x8 At[4][2], B0[2][2], B1[2][2];
    const char* cA = (const char*)g.A + (size_t)cur.pm * tstep; const char* cB = (const char*)g.Bt + (size_t)cur.pn * tstep;
    S.a_ready(cur);
    if constexpr (SP2) {
        PG8_STAGE(PG8_SB(0, 0), cB, voffB); PG8_STAGE(PG8_SB(0, 1), cB + hstep, voffB); PG8_STAGE(PG8_SA(0, 0), cA, voffA); PG8_STAGE(PG8_SA(0, 1), cA + hstep, voffA);
        if (wr == 1) PG8_BAR;
        PG8_WAIT_V(2); PG8_BAR;
        PG8_STAGE(PG8_SB(1, 0), cB + kstep, voffB); PG8_STAGE(PG8_SA(1, 0), cA + kstep, voffA); PG8_STAGE(PG8_SB(1, 1), cB + hstep + kstep, voffB);
        PG8_WAIT_V(6); PG8_BAR;
    } else {
        PG8_STAGE(PG8_SB(0, 0), cB, voffB); PG8_STAGE(PG8_SA(0, 0), cA, voffA); PG8_STAGE(PG8_SB(0, 1), cB + hstep, voffB); PG8_STAGE(PG8_SA(0, 1), cA + hstep, voffA);
        if (wr == 1) PG8_BAR;
        PG8_WAIT_V(4); PG8_BAR;
        PG8_STAGE(PG8_SB(1, 0), cB + kstep, voffB); PG8_STAGE(PG8_SA(1, 0), cA + kstep, voffA); PG8_STAGE(PG8_SB(1, 1), cB + hstep + kstep, voffB);
        PG8_WAIT_V(6); PG8_BAR;
    }
    for (;;) {
        const bool has_next = S.next(ui + 1, nxt);
        const char* nA = has_next ? (const char*)g.A + (size_t)nxt.pm * tstep : cA; const char* nB = has_next ? (const char*)g.Bt + (size_t)nxt.pn * tstep : cB;
        for (int t = 0; t < nt; t += 2) {
            const bool last = (t == nt - 2);
            const char* a1 = cA + (size_t)(t + 1) * kstep;
            const char* a2 = last ? nA : cA + (size_t)(t + 2) * kstep; const char* b2 = last ? nB : cB + (size_t)(t + 2) * kstep;
            const char* a3 = a2 + kstep; const char* b3 = b2 + kstep;
            if (last && has_next) S.a_ready(nxt);
            if constexpr (SP2) {
            PG8_LDB(B0, 0, 0); PG8_LDB(B1, 0, 1); PG8_SCHED; PG8_LDA(At, 0, 0); PG8_STAGE(PG8_SA(1, 1), a1 + hstep, voffA);
            PG8_WAIT_V(8); PG8_WAIT_L(0); PG8_BAR; PG8_MMA(0, 0, At, B0); PG8_MMA(0, 1, At, B1); PG8_BAR; PG8_SCHED;
            PG8_LDA(At, 0, 1); PG8_STAGE(PG8_SB(0, 0), b2, voffB); PG8_STAGE(PG8_SB(0, 1), b2 + hstep, voffB); PG8_STAGE(PG8_SA(0, 0), a2, voffA);
            PG8_WAIT_V(8); PG8_WAIT_L(0); PG8_BAR; PG8_MMA(1, 0, At, B0); PG8_MMA(1, 1, At, B1); PG8_BAR; PG8_SCHED;
            PG8_LDB(B0, 1, 0); PG8_LDB(B1, 1, 1); PG8_SCHED; PG8_LDA(At, 1, 0); PG8_STAGE(PG8_SA(0, 1), a2 + hstep, voffA);
            PG8_WAIT_V(8); PG8_WAIT_L(0); PG8_BAR; PG8_MMA(0, 0, At, B0); PG8_MMA(0, 1, At, B1); PG8_BAR; PG8_SCHED;
            PG8_LDA(At, 1, 1); PG8_STAGE(PG8_SB(1, 0), b3, voffB); PG8_STAGE(PG8_SB(1, 1), b3 + hstep, voffB); PG8_STAGE(PG8_SA(1, 0), a3, voffA);
            PG8_WAIT_V(8); PG8_WAIT_L(0); PG8_BAR; PG8_MMA(1, 0, At, B0); PG8_MMA(1, 1, At, B1); PG8_BAR; PG8_SCHED;
            } else {
            PG8_LDB(B0, 0, 0); PG8_SCHED; PG8_LDA(At, 0, 0); PG8_STAGE(PG8_SA(1, 1), a1 + hstep, voffA);
            PG8_WAIT_L(8); PG8_BAR; PG8_WAIT_L(0); PG8_MMA(0, 0, At, B0); PG8_BAR; PG8_SCHED;
            PG8_LDB(B1, 0, 1); PG8_STAGE(PG8_SB(0, 0), b2, voffB);
            PG8_BAR; PG8_WAIT_L(0); PG8_MMA(0, 1, At, B1); PG8_BAR;
            PG8_LDA(At, 0, 1); PG8_STAGE(PG8_SA(0, 0), a2, voffA);
            PG8_BAR; PG8_WAIT_L(0); PG8_MMA(1, 0, At, B0); PG8_BAR; PG8_SCHED;
            PG8_STAGE(PG8_SB(0, 1), b2 + hstep, voffB);
            PG8_WAIT_V(6); PG8_BAR; PG8_MMA(1, 1, At, B1); PG8_BAR;
            PG8_LDB(B0, 1, 0); PG8_SCHED; PG8_LDA(At, 1, 0); PG8_STAGE(PG8_SA(0, 1), a2 + hstep, voffA);
            PG8_WAIT_L(8); PG8_BAR; PG8_WAIT_L(0); PG8_MMA(0, 0, At, B0); PG8_BAR; PG8_SCHED;
            PG8_LDB(B1, 1, 1); PG8_STAGE(PG8_SB(1, 0), b3, voffB);
            PG8_BAR; PG8_WAIT_L(0); PG8_MMA(0, 1, At, B1); PG8_BAR;
            PG8_LDA(At, 1, 1); PG8_STAGE(PG8_SA(1, 0), a3, voffA);
            PG8_BAR; PG8_WAIT_L(0); PG8_MMA(1, 0, At, B0); PG8_BAR; PG8_SCHED;
            PG8_STAGE(PG8_SB(1, 1), b3 + hstep, voffB);
            PG8_WAIT_V(6); PG8_BAR; PG8_MMA(1, 1, At, B1); PG8_BAR;
            }
        }
        if constexpr (ALIGN_EPI) { if (wr == 0) PG8_BAR; }
        if constexpr (!Epi::AFTER_DRAIN) { E(acc, cur, wr, wc, fr, fq); S.done(cur); }
        if (!has_next) break;
#pragma unroll
        for (int a = 0; a < 2; ++a)
#pragma unroll
            for (int b = 0; b < 2; ++b)
#pragma unroll
                for (int m = 0; m < 4; ++m)
#pragma unroll
                    for (int n = 0; n < 2; ++n) acc[a][b][m][n] = (f32x4){0.f, 0.f, 0.f, 0.f};
        cur = nxt; cA = nA; cB = nB; ++ui;
        if constexpr (ALIGN_EPI) { if (wr == 1) PG8_BAR; }
    }
    PG8_WAIT_V(0);
    if constexpr (!ALIGN_EPI) { if (wr == 0) PG8_BAR; }
    PG8_BAR;
    if constexpr (Epi::AFTER_DRAIN) { E.fused(acc, cur, wr, wc, fr, fq, lds, wid, lane); S.done(cur); }
#undef PG8_SA
#undef PG8_SB
#undef PG8_STAGE
#undef PG8_LDA
#undef PG8_LDB
#undef PG8_MMA
#undef PG8_WAIT_V
#undef PG8_WAIT_L
#undef PG8_BAR
#undef PG8_SCHED
}
}
#define LAS __attribute__((address_space(3)))
typedef unsigned short bf16;
typedef short s16x4 __attribute__((ext_vector_type(4)));
typedef short bf16x8 __attribute__((ext_vector_type(8)));
typedef float f32x4 __attribute__((ext_vector_type(4)));
typedef float f32x16 __attribute__((ext_vector_type(16)));
typedef unsigned u32x2 __attribute__((ext_vector_type(2)));
typedef unsigned u32x4 __attribute__((ext_vector_type(4)));
constexpr int SEQ = 8192, NTOK = 16384, DM = 2048;
constexpr float LOG2E = 1.4426950408889634f;
__device__ __forceinline__ unsigned cvtpk(float lo, float hi) { unsigned r; asm volatile("v_cvt_pk_bf16_f32 %0, %1, %2" : "=v"(r) : "v"(lo), "v"(hi)); return r; }
__device__ __forceinline__ unsigned offb(unsigned row, unsigned ch) { return 256u * row + 16u * (ch ^ (((row & 3) << 2) | ((row >> 2) & 3))); }
__device__ __forceinline__ int pislot(int rho) { const int a = rho >> 3, h = (rho >> 2) & 1, c = rho & 3; return 16 * (a >> 1) + 8 * h + 4 * (a & 1) + c; }
__device__ __forceinline__ bf16x8 pack8(const f32x16& s, int base) {
    u32x4 w; w.x = cvtpk(s[base + 0], s[base + 1]); w.y = cvtpk(s[base + 2], s[base + 3]); w.z = cvtpk(s[base + 4], s[base + 5]); w.w = cvtpk(s[base + 6], s[base + 7]);
    return __builtin_bit_cast(bf16x8, w); }
__device__ __forceinline__ bf16x8 tr8(LAS unsigned char* p0, LAS unsigned char* p1) {
    const s16x4 a = __builtin_amdgcn_ds_read_tr16_b64_v4i16((LAS s16x4*)p0), b = __builtin_amdgcn_ds_read_tr16_b64_v4i16((LAS s16x4*)p1);
    bf16x8 v; v.s0 = a.x; v.s1 = a.y; v.s2 = a.z; v.s3 = a.w; v.s4 = b.x; v.s5 = b.y; v.s6 = b.z; v.s7 = b.w; return v; }

__device__ __forceinline__ void store_pair16(bf16* p, int hi, u32x2 a  , u32x2 b  ) {
    const auto r0 = __builtin_amdgcn_permlane32_swap(a.x, b.x, false, false); const auto r1 = __builtin_amdgcn_permlane32_swap(a.y, b.y, false, false);
    u32x4 w; w.x = r0[0]; w.y = r1[0]; w.z = r0[1]; w.w = r1[1];
    *(u32x4*)(p + 8 * hi) = w;
}
__device__ __forceinline__ void fox_attn_phase(LAS unsigned char* lds, const bf16* Q, bf16* Oo, const bf16* K, const bf16* V, const float* D2, const float* gq, const float* gk, int G, int c) {
    int tid_ = threadIdx.x; asm volatile("" : "+v"(tid_));
    const int tid = tid_, lane = tid & 63, w = __builtin_amdgcn_readfirstlane(tid >> 6), hi = lane >> 5, l32 = lane & 31;
    float mq = 0.f, mk = 0.f;
    for (int i = 0; i < 128; ++i) { mq = fmaxf(mq, fabsf(gq[i])); mk = fmaxf(mk, fabsf(gk[i])); }
    const float B2 = 1.03f * 11.313708499f * LOG2E * mq * mk, PRUNE = 2.0f * B2 + 40.0f;
    const unsigned krow = (unsigned)pislot(l32), kx = ((krow & 3) << 2) | ((krow >> 2) & 3);
    unsigned kaddr[8];
#pragma unroll
    for (int s = 0; s < 8; ++s) kaddr[s] = 256u * krow + 16u * ((unsigned)(2 * s + hi) ^ kx);
    unsigned vaddr[4][2];
    { const unsigned blk = (lane >> 4) & 1, q4 = (lane & 15) >> 2, p = lane & 3;
#pragma unroll
      for (int cc = 0; cc < 4; ++cc)
#pragma unroll
        for (int t = 0; t < 2; ++t) vaddr[cc][t] = 16384u + offb(8 * hi + 4 * t + q4, 4 * cc + 2 * blk + (p >> 1)) + 8 * (p & 1); }
    const int srow = tid >> 4, sch = tid & 15;
    const unsigned soff0 = offb(srow, sch), soff1 = offb(srow + 32, sch);
    for (int it = 0;; ++it) {
        const int L = it * G + ((it & 1) ? (G - 1 - c) : c); if (L >= 1024) break;
        const int qb = 31 - (L >> 5), bh = L & 31, b = bh >> 4, h = bh & 15;
        const int q0 = 256 * qb, q0w = q0 + 32 * w, jend = 4 * qb + 3, jwl = (q0w + 31) >> 6;
        const size_t tok0 = (size_t)b * SEQ;
        const float* d2 = D2 + (size_t)bh * SEQ;
        const bf16* Qp = Q + (tok0 + q0w + l32) * DM + h * 128 + 8 * hi;
        bf16x8 qf[8];
#pragma unroll
        for (int s = 0; s < 8; ++s) qf[s] = *(const bf16x8*)(Qp + 16 * s);
        const int jstart = 0;
        const bf16* Kg = K + (tok0 + srow) * DM + h * 128 + sch * 8;
        const bf16* Vg = V + (tok0 + srow) * DM + h * 128 + sch * 8;
        u32x4 pk0, pk1, pv0, pv1; float pd = 0.f;
#define FOX_LOAD(J) do { const size_t o_ = (size_t)(64 * (J)) * DM; pk0 = *(const u32x4*)(Kg + o_); pk1 = *(const u32x4*)(Kg + o_ + 32 * DM); pv0 = *(const u32x4*)(Vg + o_); pv1 = *(const u32x4*)(Vg + o_ + 32 * DM); \
        if (tid < 64) pd = d2[64 * (J) + tid]; } while (0)
#define FOX_STORE(BUF) do { LAS unsigned char* b_ = lds + (BUF) * 33024; *(LAS u32x4*)(b_ + soff0) = pk0; *(LAS u32x4*)(b_ + soff1) = pk1; *(LAS u32x4*)(b_ + 16384 + soff0) = pv0; *(LAS u32x4*)(b_ + 16384 + soff1) = pv1; \
        if (tid < 64) *(LAS float*)(b_ + 32768 + 4 * tid) = pd; } while (0)
        FOX_LOAD(jend);
        f32x16 O[4];
#pragma unroll
        for (int cc = 0; cc < 4; ++cc)
#pragma unroll
            for (int r = 0; r < 16; ++r) O[cc][r] = 0.f;
        float lrun = 0.f;
        const int qpos = q0w + l32;
        const float d2q = d2[qpos], mfix = d2q + B2;
        LAS float* red = (LAS float*)(lds + 2 * 33024);
        __syncthreads();
        FOX_STORE(jend & 1);
        if (jstart < jend) FOX_LOAD(jend - 1);
        __syncthreads();
        for (int j = jend; j >= jstart; --j) {
            if (j > jstart) FOX_STORE((j - 1) & 1);
            if (j - 1 > jstart) FOX_LOAD(j - 2);
            LAS unsigned char* tb = lds + (j & 1) * 33024;
            const float bound = d2[64 * (j > 0 ? j : 1) - 1] + __builtin_amdgcn_logf((float)(64 * (j > 0 ? j : 1))) + 24.0f;
            if (j <= jwl) {
                f32x16 S0, S1;
                { const LAS float* dl = (const LAS float*)(tb + 32768) + 8 * hi;
                  const f32x4 a0 = *(const LAS f32x4*)(dl), a1 = *(const LAS f32x4*)(dl + 4), a2 = *(const LAS f32x4*)(dl + 16), a3 = *(const LAS f32x4*)(dl + 20);
                  const f32x4 b0 = *(const LAS f32x4*)(dl + 32), b1 = *(const LAS f32x4*)(dl + 36), b2 = *(const LAS f32x4*)(dl + 48), b3 = *(const LAS f32x4*)(dl + 52);
#pragma unroll
                  for (int e = 0; e < 4; ++e) { S0[e] = a0[e]; S0[4 + e] = a1[e]; S0[8 + e] = a2[e]; S0[12 + e] = a3[e]; S1[e] = b0[e]; S1[4 + e] = b1[e]; S1[8 + e] = b2[e]; S1[12 + e] = b3[e]; } }
#pragma unroll
                for (int hb = 0; hb < 2; ++hb) {
                    bf16x8 ka[4], kc[4];
#pragma unroll
                    for (int s = 0; s < 4; ++s) { ka[s] = *(const LAS bf16x8*)(tb + kaddr[4 * hb + s]); kc[s] = *(const LAS bf16x8*)(tb + kaddr[4 * hb + s] + 8192); }
                    __builtin_amdgcn_sched_barrier(0);
#pragma unroll
                    for (int s = 0; s < 4; ++s) { S0 = __builtin_amdgcn_mfma_f32_32x32x16_bf16(ka[s], qf[4 * hb + s], S0, 0, 0, 0); S1 = __builtin_amdgcn_mfma_f32_32x32x16_bf16(kc[s], qf[4 * hb + s], S1, 0, 0, 0); }
                    __builtin_amdgcn_sched_barrier(0);
                }
                if (64 * j + 63 > q0w) {
                    const int kb = 64 * j + 8 * hi;
#pragma unroll
                    for (int r = 0; r < 16; ++r) { const int key = kb + 16 * (r >> 3) + (r & 7); if (key > qpos) S0[r] = -INFINITY; if (key + 32 > qpos) S1[r] = -INFINITY; }
                }
                float ps = 0.f;
#pragma unroll
                for (int r = 0; r < 16; ++r) { S0[r] = __builtin_amdgcn_exp2f(S0[r] - mfix); S1[r] = __builtin_amdgcn_exp2f(S1[r] - mfix); ps += S0[r] + S1[r]; }
                lrun += ps;
                bf16x8 P[4]; P[0] = pack8(S0, 0); P[1] = pack8(S0, 8); P[2] = pack8(S1, 0); P[3] = pack8(S1, 8);
                { bf16x8 va[4], vb[4];
#pragma unroll
                  for (int cc = 0; cc < 4; ++cc) va[cc] = tr8(tb + vaddr[cc][0], tb + vaddr[cc][1]);
#pragma unroll
                  for (int ks = 0; ks < 4; ++ks) {
                      if (ks < 3) {
#pragma unroll
                          for (int cc = 0; cc < 4; ++cc) { const bf16x8 t = tr8(tb + vaddr[cc][0] + 4096 * (ks + 1), tb + vaddr[cc][1] + 4096 * (ks + 1)); if (ks & 1) va[cc] = t; else vb[cc] = t; } }
                      __builtin_amdgcn_sched_barrier(0);
#pragma unroll
                      for (int cc = 0; cc < 4; ++cc) O[cc] = __builtin_amdgcn_mfma_f32_32x32x16_bf16((ks & 1) ? vb[cc] : va[cc], P[ks], O[cc], 0, 0, 0);
                      __builtin_amdgcn_sched_barrier(0);
                  } }
            }
            {
              const int okw = __all(bound <= __builtin_amdgcn_logf(lrun) + d2q);
              if (lane == 0) red[(j & 1) * 8 + w] = okw ? 1.0f : 0.0f; }
            __syncthreads();
            if (j > jstart) {
                const f32x4 ra = *(const LAS f32x4*)(red + (j & 1) * 8), rb = *(const LAS f32x4*)(red + (j & 1) * 8 + 4);
                const float mall = fminf(fminf(fminf(ra[0], ra[1]), fminf(ra[2], ra[3])), fminf(fminf(rb[0], rb[1]), fminf(rb[2], rb[3])));
                if (mall > 0.5f) break;
            }
        }
#undef FOX_LOAD
#undef FOX_STORE
        lrun += __shfl_xor(lrun, 32);
        const float inv = 1.0f / lrun;
        bf16* Op = Oo + (tok0 + q0w + l32) * DM + h * 128;
#pragma unroll
        for (int cc = 0; cc < 4; ++cc)
#pragma unroll
            for (int g = 0; g < 4; g += 2) { u32x2 wa, wb;
                wa.x = cvtpk(O[cc][4 * g] * inv, O[cc][4 * g + 1] * inv); wa.y = cvtpk(O[cc][4 * g + 2] * inv, O[cc][4 * g + 3] * inv);
                wb.x = cvtpk(O[cc][4 * g + 4] * inv, O[cc][4 * g + 5] * inv); wb.y = cvtpk(O[cc][4 * g + 6] * inv, O[cc][4 * g + 7] * inv);
                store_pair16(Op + 32 * cc + 8 * g, hi, wa, wb); }
    }
    __syncthreads();
}
__device__ __forceinline__ void lds_k4(bf16x8 (&k)[4], unsigned a0, unsigned a1, unsigned a2, unsigned a3) {
    asm volatile("ds_read_b128 %0, %4\n\tds_read_b128 %1, %5\n\tds_read_b128 %2, %6\n\tds_read_b128 %3, %7\n\ts_waitcnt lgkmcnt(0)"
                 : "=&v"(k[0]), "=&v"(k[1]), "=&v"(k[2]), "=&v"(k[3]) : "v"(a0), "v"(a1), "v"(a2), "v"(a3) : "memory");
}
template <int OFF> __device__ __forceinline__ void lds_v4(bf16x8 (&v)[4], unsigned a0, unsigned a1, unsigned b0, unsigned b1) {
    s16x4 r0, r1, r2, r3, r4, r5, r6, r7;
    asm volatile("ds_read_b64_tr_b16 %0, %8 offset:%12\n\tds_read_b64_tr_b16 %1, %9 offset:%12\n\tds_read_b64_tr_b16 %2, %8 offset:%13\n\tds_read_b64_tr_b16 %3, %9 offset:%13\n\t"
                 "ds_read_b64_tr_b16 %4, %10 offset:%12\n\tds_read_b64_tr_b16 %5, %11 offset:%12\n\tds_read_b64_tr_b16 %6, %10 offset:%13\n\tds_read_b64_tr_b16 %7, %11 offset:%13\n\ts_waitcnt lgkmcnt(0)"
                 : "=&v"(r0), "=&v"(r1), "=&v"(r2), "=&v"(r3), "=&v"(r4), "=&v"(r5), "=&v"(r6), "=&v"(r7) : "v"(a0), "v"(a1), "v"(b0), "v"(b1), "i"(OFF), "i"(OFF + 4096) : "memory");
    v[0] = __builtin_shufflevector(r0, r1, 0, 1, 2, 3, 4, 5, 6, 7); v[1] = __builtin_shufflevector(r2, r3, 0, 1, 2, 3, 4, 5, 6, 7);
    v[2] = __builtin_shufflevector(r4, r5, 0, 1, 2, 3, 4, 5, 6, 7); v[3] = __builtin_shufflevector(r6, r7, 0, 1, 2, 3, 4, 5, 6, 7);
}
__device__ __forceinline__ void dil_pv_asm(f32x16 (&Oa)[8], unsigned vt, unsigned va0, unsigned va1, const bf16x8 (&P)[2]) {
    bf16x8 v[4];
#define DIL_PV4(C0, OFF, X0, X1) do { lds_v4<OFF>(v, vt + (va0 ^ (X0)), vt + (va1 ^ (X0)), vt + (va0 ^ (X1)), vt + (va1 ^ (X1))); \
        Oa[C0] = __builtin_amdgcn_mfma_f32_32x32x16_bf16(v[0], P[0], Oa[C0], 0, 0, 0); Oa[C0 + 1] = __builtin_amdgcn_mfma_f32_32x32x16_bf16(v[2], P[0], Oa[C0 + 1], 0, 0, 0); \
        Oa[C0] = __builtin_amdgcn_mfma_f32_32x32x16_bf16(v[1], P[1], Oa[C0], 0, 0, 0); Oa[C0 + 1] = __builtin_amdgcn_mfma_f32_32x32x16_bf16(v[3], P[1], Oa[C0 + 1], 0, 0, 0); \
        asm volatile("" : "+v"(va0), "+v"(va1)); } while (0)
    DIL_PV4(0, 0, 0u, 64u); DIL_PV4(2, 0, 128u, 192u); DIL_PV4(4, 8192, 0u, 64u); DIL_PV4(6, 8192, 128u, 192u);
#undef DIL_PV4
}
template <int RG> __device__ __forceinline__ void dil_cinit(f32x16& S, int kb0, int tq, int hi, float slope2, float mfix) {
    const float base = -slope2 * (float)(tq - kb0 - RG * 8 * hi) - mfix;
#pragma unroll
    for (int r = 0; r < 16; ++r) S[r] = __builtin_fmaf(slope2, (float)(RG * (16 * (r >> 3) + (r & 7))), base);
}
template <int RG> __device__ __forceinline__ void dil_softmax(f32x16& S, int kb0, int tq, int hi, float& lrun, bf16x8 (&P)[2]) {
    const int d0 = tq - kb0 - RG * 8 * hi; const unsigned lim = (unsigned)(tq < 128 * RG ? tq : 128 * RG);
    float ps = 0.f;
#pragma unroll
    for (int r = 0; r < 16; ++r) { const unsigned dist = (unsigned)(d0 - RG * (16 * (r >> 3) + (r & 7)));
        const float e = __builtin_amdgcn_exp2f(S[r]); S[r] = (dist <= lim) ? e : 0.f; ps += S[r]; }
    lrun += ps; P[0] = pack8(S, 0); P[1] = pack8(S, 8);
}
__device__ __forceinline__ void dil_pv(f32x16 (&Oa)[8], LAS unsigned char* vt, unsigned va0, unsigned va1, const bf16x8 (&P)[2]) {
    asm volatile("" : "+v"(va0), "+v"(va1));
#pragma unroll
    for (int cc = 0; cc < 8; ++cc)
#pragma unroll
        for (int ks = 0; ks < 2; ++ks) { LAS unsigned char* vb = vt + (cc >> 2) * 8192 + 4096 * ks;
            const bf16x8 vf = tr8(vb + (va0 ^ ((cc & 3) << 6)), vb + (va1 ^ ((cc & 3) << 6)));
            Oa[cc] = __builtin_amdgcn_mfma_f32_32x32x16_bf16(vf, P[ks], Oa[cc], 0, 0, 0); }
}
template <int RG, int NBLK, int NSTREAM, int BPS  >
__device__ __forceinline__ void dil_shared_group(LAS unsigned char* lds_all, f32x16 (&Oa)[8], float& lrun, const bf16* Qp, const bf16* Kg  , const bf16* Vg  ,
                                                 int tokb0  , int tq, int w, int lane, int hi, const unsigned kbase, const unsigned kx, const unsigned va0, const unsigned va1, float slope2, float mfix) {
    constexpr int NW = 8 / NSTREAM, NSLOT = 24 / NW, NSTEP = NBLK / BPS, BUFB = BPS * 24576;
    static_assert(NBLK % BPS == 0, "blocks per step");
    const int stream = (NSTREAM == 1) ? 0 : (w >> 2), wi = w & (NW - 1);
    LAS unsigned char* sb = lds_all + stream * (2 * BUFB);
    const int drow = lane >> 4, dchp = lane & 15;
    bf16x8 qf[8];
#pragma unroll
    for (int s = 0; s < 8; ++s) qf[s] = *(const bf16x8*)(Qp + 16 * s);
#define DIL_TDMA(M, BUF) do { _Pragma("unroll") for (int bb_ = 0; bb_ < BPS; ++bb_) { const int tb_ = tokb0 + RG * 32 * ((M) * BPS + bb_); _Pragma("unroll") for (int q_ = 0; q_ < NSLOT; ++q_) { const int slot_ = wi + NW * q_; \
        const int row_ = 4 * (slot_ & 7) + drow; const int tk_ = tb_ + RG * row_; const int ch_ = dchp ^ (((row_ & 3) << 2) | ((row_ >> 2) & 3)); \
        const bf16* src_ = (slot_ < 8) ? (Kg + (long)tk_ * 3072 + ch_ * 8) : (Vg + (long)tk_ * DM + ((slot_ - 8) >> 3) * 128 + ch_ * 8); \
        __builtin_amdgcn_global_load_lds((const unsigned*)src_, (LAS unsigned*)(sb + (BUF) * BUFB + bb_ * 24576 + slot_ * 1024), 16, 0, 0); } } } while (0)
    DIL_TDMA(0, 0);
    asm volatile("s_waitcnt vmcnt(0)" ::: "memory");
    __syncthreads();
#pragma unroll 1
    for (int m = 0; m < NSTEP; ++m) {
        if (m + 1 < NSTEP) DIL_TDMA(m + 1, (m + 1) & 1);
#pragma unroll
        for (int bb = 0; bb < BPS; ++bb) {
            LAS unsigned char* tb = sb + (m & 1) * BUFB + bb * 24576;
            const int kb0 = tokb0 + RG * 32 * (m * BPS + bb);
            if (kb0 + RG * 31 >= 0) {
                f32x16 S;
                dil_cinit<RG>(S, kb0, tq, hi, slope2, mfix);
                const unsigned tba = (unsigned)(size_t)tb + kbase;
#pragma unroll
                for (int hb = 0; hb < 2; ++hb) { bf16x8 kf[4];
                    lds_k4(kf, tba + 16u * ((unsigned)(8 * hb + 0 + hi) ^ kx), tba + 16u * ((unsigned)(8 * hb + 2 + hi) ^ kx), tba + 16u * ((unsigned)(8 * hb + 4 + hi) ^ kx), tba + 16u * ((unsigned)(8 * hb + 6 + hi) ^ kx));
#pragma unroll
                    for (int s = 0; s < 4; ++s) S = __builtin_amdgcn_mfma_f32_32x32x16_bf16(kf[s], qf[4 * hb + s], S, 0, 0, 0); }
                bf16x8 P[2];
                dil_softmax<RG>(S, kb0, tq, hi, lrun, P);
                dil_pv_asm(Oa, (unsigned)(size_t)tb + 8192u, va0, va1, P);
            }
        }
        asm volatile("s_waitcnt vmcnt(0)" ::: "memory");
        __syncthreads();
    }
#undef DIL_TDMA
}
__device__ __forceinline__ void dil_attn_phase(LAS unsigned char* lds_all, const bf16* Qd, const bf16* Kd, const bf16* Vd, bf16* O, const float* gq, const float* gk, int G, int c) {
    float mfix = 0.f;
    for (int g = 0; g < 3; ++g) { float mq = 0.f, mk = 0.f;
        for (int i = 0; i < 128; ++i) { mq = fmaxf(mq, fabsf(gq[g * 128 + i])); mk = fmaxf(mk, fabsf(gk[g * 128 + i])); }
        mfix = fmaxf(mfix, 1.03f * 11.313708499f * LOG2E * mq * mk); }
    mfix = __builtin_bit_cast(float, __builtin_amdgcn_readfirstlane(__builtin_bit_cast(int, mfix)));
    for (int it = 0;; ++it) {
        const int vc = (G % 8 == 0) ? (c % 8) * (G / 8) + c / 8 : c;
        const int u = it * G + vc; if (u >= 512) break;
        int tid_ = threadIdx.x; asm volatile("" : "+v"(tid_));
        const int tid = tid_, lane = tid & 63, w = __builtin_amdgcn_readfirstlane(tid >> 6), hi = lane >> 5, l32 = lane & 31;
        LAS unsigned char* ldsw = lds_all + w * 16384;
        unsigned va0, va1;
        { const unsigned blk = (lane >> 4) & 1, q4 = (lane & 15) >> 2, p = lane & 3;
          va0 = offb(8 * hi + q4, 2 * blk + (p >> 1)) + 8 * (p & 1); va1 = offb(8 * hi + 4 + q4, 2 * blk + (p >> 1)) + 8 * (p & 1); }
        const int kslot = pislot(l32);
        const unsigned kx = ((kslot & 3) << 2) | ((kslot >> 2) & 3), kbase = 256u * kslot;
        const int half = u & 1, ab = (u >> 1) & 15, bh = u >> 5, b = bh >> 3, h = bh & 7;
        const int cl = 2 * half + (w >> 2), rho = 4 * (w & 3) + cl;
        const size_t tok0 = (size_t)b * SEQ;
        const int tq0 = 512 * ab + rho, tq = tq0 + 16 * l32;
        const bf16* Vg = Vd + tok0 * DM + h * 256;
        f32x16 Oa[8];
#pragma unroll
        for (int cc = 0; cc < 8; ++cc)
#pragma unroll
            for (int r = 0; r < 16; ++r) Oa[cc][r] = 0.f;
        float lrun = 0.f;
        __syncthreads();
        {
            const float slope2 = __builtin_bit_cast(float, __builtin_amdgcn_readfirstlane(__builtin_bit_cast(int, __builtin_amdgcn_exp2f((float)(h + 1) * (-8.0f / 24.0f)) * LOG2E)));
            dil_shared_group<1, 20, 1, 2>(lds_all, Oa, lrun, Qd + (tok0 + tq) * 3072 + h * 128 + 8 * hi, Kd + tok0 * 3072 + h * 128, Vg, 32 * (16 * ab - 4), tq, w, lane, hi, kbase, kx, va0, va1, slope2, mfix);
        }
        {
            const float slope2 = __builtin_bit_cast(float, __builtin_amdgcn_readfirstlane(__builtin_bit_cast(int, __builtin_amdgcn_exp2f((float)(8 + h + 1) * (-8.0f / 24.0f)) * LOG2E)));
            dil_shared_group<4, 8, 2, 1>(lds_all, Oa, lrun, Qd + (tok0 + tq) * 3072 + (8 + h) * 128 + 8 * hi, Kd + tok0 * 3072 + (8 + h) * 128, Vg, 4 * 32 * (4 * ab - 4) + cl, tq, w, lane, hi, kbase, kx, va0, va1, slope2, mfix);
        }
        {
            constexpr int rg = 16;
            int t3 = threadIdx.x; asm volatile("" : "+v"(t3));
            const int lane3 = t3 & 63, hi = lane3 >> 5, l32 = lane3 & 31, kslot = pislot(l32), tq = tq0 + 16 * l32, drow = lane3 >> 4, dchp = lane3 & 15;
            unsigned va0, va1;
            { const unsigned blk = (lane3 >> 4) & 1, q4 = (lane3 & 15) >> 2, p = lane3 & 3;
              va0 = offb(8 * hi + q4, 2 * blk + (p >> 1)) + 8 * (p & 1); va1 = offb(8 * hi + 4 + q4, 2 * blk + (p >> 1)) + 8 * (p & 1); }
            const float slope2 = __builtin_bit_cast(float, __builtin_amdgcn_readfirstlane(__builtin_bit_cast(int, __builtin_amdgcn_exp2f((float)(16 + h + 1) * (-8.0f / 24.0f)) * LOG2E)));
            const bf16* Qp = Qd + (tok0 + tq) * 3072 + (16 + h) * 128 + 8 * hi;
            const bf16* Kg = Kd + tok0 * 3072 + (16 + h) * 128 + 8 * hi;
            const int tlo = tq0 - 128 * rg;
            bf16x8 qf[8];
#pragma unroll
            for (int s = 0; s < 8; ++s) qf[s] = *(const bf16x8*)(Qp + 16 * s);
#define DIL_VDMA(KB0) do { _Pragma("unroll") for (int i_ = 0; i_ < 16; ++i_) { const int row_ = 4 * (i_ & 7) + drow; const int tk_ = (KB0) + rg * row_; \
        const int ch_ = dchp ^ (((row_ & 3) << 2) | ((row_ >> 2) & 3)); \
        __builtin_amdgcn_global_load_lds((const unsigned*)(Vg + (long)tk_ * DM + (i_ >> 3) * 128 + ch_ * 8), (LAS unsigned*)(ldsw + i_ * 1024), 16, 0, 0); } } while (0)
#define DIL_KLOAD(KB0) do { const int tkk_ = (KB0) + rg * kslot; const bf16* Kp_ = Kg + (long)tkk_ * 3072; \
        _Pragma("unroll") for (int s_ = 0; s_ < 8; ++s_) kf[s_] = *(const bf16x8*)(Kp_ + 16 * s_); } while (0)
            int kb = 0;
            while (tlo + rg * (32 * kb + 31) < 0) ++kb;
#pragma unroll 1
            for (; kb < 5; ++kb) {
                const int kb0 = tlo + rg * 32 * kb;
                DIL_VDMA(kb0);
                f32x16 S;
                dil_cinit<rg>(S, kb0, tq, hi, slope2, mfix);
                { const bf16* Kp = Kg + (long)(kb0 + rg * kslot) * 3072;
                  bf16x8 kf[8];
#pragma unroll
                  for (int s = 0; s < 8; ++s) kf[s] = *(const bf16x8*)(Kp + 16 * s);
                  asm volatile("" ::: "memory");
#pragma unroll
                  for (int s = 0; s < 8; ++s) S = __builtin_amdgcn_mfma_f32_32x32x16_bf16(kf[s], qf[s], S, 0, 0, 0);
                  asm volatile("" ::: "memory"); }
                bf16x8 P[2];
                dil_softmax<rg>(S, kb0, tq, hi, lrun, P);
                asm volatile("s_waitcnt vmcnt(0)" ::: "memory");
                dil_pv(Oa, ldsw, va0, va1, P);
                asm volatile("s_waitcnt lgkmcnt(0)" ::: "memory");
            }
#undef DIL_VDMA
#undef DIL_KLOAD
        }
        lrun += __shfl_xor(lrun, 32);
        const float inv = 1.0f / lrun;
        int t2 = threadIdx.x; asm volatile("" : "+v"(t2));
        bf16* Op = O + (tok0 + tq0 + 16 * (t2 & 31)) * DM + h * 256;
        const int hi2 = (t2 >> 5) & 1;
#pragma unroll
        for (int cc = 0; cc < 8; ++cc)
#pragma unroll
            for (int gg = 0; gg < 4; gg += 2) { u32x2 wa, wb;
                wa.x = cvtpk(Oa[cc][4 * gg] * inv, Oa[cc][4 * gg + 1] * inv); wa.y = cvtpk(Oa[cc][4 * gg + 2] * inv, Oa[cc][4 * gg + 3] * inv);
                wb.x = cvtpk(Oa[cc][4 * gg + 4] * inv, Oa[cc][4 * gg + 5] * inv); wb.y = cvtpk(Oa[cc][4 * gg + 6] * inv, Oa[cc][4 * gg + 7] * inv);
                store_pair16(Op + 32 * cc + 8 * gg, hi2, wa, wb); }
    }
    __syncthreads();
}
#define XB_TMO      128
#define XB_XCNT(j)  (256  + 64 * (j))
#define XB_XSUB(j)  (1280 + 64 * (j))
#define XB_XGEN(j)  (2304 + 64 * (j))
#define XB_TOP      3328
#define XB_TOPGEN   3392
#define XCD_BAR_WORDS 3456
#define XB_SPIN_CAP (1u << 18)

__device__ __forceinline__ unsigned xb_ld(unsigned* p)              { return __hip_atomic_load(p, __ATOMIC_RELAXED, __HIP_MEMORY_SCOPE_AGENT); }
__device__ __forceinline__ unsigned xb_add(unsigned* p, unsigned v) { return __hip_atomic_fetch_add(p, v, __ATOMIC_RELAXED, __HIP_MEMORY_SCOPE_AGENT); }
__device__ __forceinline__ unsigned xb_xcc_id() { return (unsigned)__builtin_amdgcn_s_getreg((3 << 11) | 20) & 0xFu; }
#define XB_SPIN(cond, bar) do { unsigned _sp = 0; while (cond) { __builtin_amdgcn_s_sleep(1); \
    if ((++_sp & 255u) == 0u) { if (xb_ld(&(bar)[XB_TMO])) break; if (_sp > XB_SPIN_CAP) { atomicAdd(&(bar)[XB_TMO], 1u); break; } } } } while (0)

struct XcdBarrier {
    unsigned* bar; unsigned x;
    volatile LAS unsigned* st;
};

__device__ __forceinline__ XcdBarrier xcd_barrier_post(unsigned* bar, volatile LAS unsigned* st) {
    XcdBarrier b; b.bar = bar; b.x = xb_xcc_id(); b.st = st;
    if (threadIdx.x == 0) (void)xb_add(&bar[XB_XCNT(b.x)], 1u);
    return b;
}
__device__ __forceinline__ void xcd_barrier_complete(unsigned* bar, unsigned x, unsigned& nloc, unsigned& nx) {
    const unsigned G = gridDim.x * gridDim.y * gridDim.z;
    unsigned sum, cnt, mine, sp = 0u;
    for (;;) {
        sum = 0u; cnt = 0u; mine = 0u;
#pragma unroll
        for (unsigned j = 0; j < 16; ++j) { const unsigned c = xb_ld(&bar[XB_XCNT(j)]); sum += c; cnt += (c > 0u) ? 1u : 0u; mine = (j == x) ? c : mine; }
        if (sum == G) break;
        __builtin_amdgcn_s_sleep(1);
        if ((++sp & 255u) == 0u) { if (xb_ld(&bar[XB_TMO])) break; if (sp > XB_SPIN_CAP) { atomicAdd(&bar[XB_TMO], 1u); break; } }
    }
    nloc = mine > 0u ? mine : 1u; nx = cnt > 0u ? cnt : 1u;
}

__device__ __forceinline__ void xcd_barrier(const XcdBarrier& b) {
    asm volatile("s_waitcnt vmcnt(0)" ::: "memory");
    __syncthreads();
    if (threadIdx.x == 0) {
        unsigned* bar = b.bar;
        __builtin_amdgcn_s_waitcnt(0);
        unsigned nloc = b.st[0], nx = b.st[1];
        if (nloc == 0u) { xcd_barrier_complete(bar, b.x, nloc, nx); b.st[0] = nloc; b.st[1] = nx; }
        const unsigned old = xb_add(&bar[XB_XSUB(b.x)], 1u);
        const unsigned gen = old / nloc;
        if (old + 1u == (gen + 1u) * nloc) {
            __builtin_amdgcn_fence(__ATOMIC_RELEASE, "agent");
            asm volatile("s_waitcnt vmcnt(0)" ::: "memory");
            const unsigned og = xb_add(&bar[XB_TOP], 1u);
            const unsigned tg = og / nx;
            if (og + 1u == (tg + 1u) * nx) xb_add(&bar[XB_TOPGEN], 1u);
            else XB_SPIN(xb_ld(&bar[XB_TOPGEN]) == tg, bar);
            __builtin_amdgcn_fence(__ATOMIC_ACQUIRE, "agent");
            xb_add(&bar[XB_XGEN(b.x)], 1u);
            asm volatile("s_waitcnt vmcnt(0)" ::: "memory");
        } else {
            XB_SPIN(xb_ld(&bar[XB_XGEN(b.x)]) == gen, bar);
            __builtin_amdgcn_fence(__ATOMIC_ACQUIRE, "agent");
            asm volatile("s_waitcnt vmcnt(0)" ::: "memory");
        }
    }
    __syncthreads();
}
constexpr size_t MiB = 1u << 20;
constexpr size_t WS_BAR = 768 * 1024;
constexpr size_t WS_SSP = 0, WS_LF = 1 * MiB, WS_D2 = 2 * MiB, WS_WF = 3 * MiB;
constexpr size_t WS_FOX_IN = 4 * MiB, WS_FOX_O = 28 * MiB, WS_DIL_IN = 36 * MiB, WS_DIL_O = 68 * MiB, WS_UP0 = 76 * MiB, WS_UP1 = 108 * MiB, WS_DN0 = 140 * MiB, WS_DN1 = 172 * MiB;
constexpr size_t WS_XB = 204 * MiB, WS_R = 268 * MiB, WS_END = 524 * MiB;
constexpr int RING_BYTES = 131072, EX_OFF = RING_BYTES, LDS_BYTES = 147456;
constexpr int NWAVES = 8;
#define REP_P0 1
#define REP_FOX 1
#define REP_DIL 1
#define LDS_WAIT() asm volatile("s_waitcnt lgkmcnt(0)" ::: "memory")
__device__ __forceinline__ unsigned f2bf(float f) { unsigned u = __builtin_bit_cast(unsigned, f); return (u + 0x7fffu + ((u >> 16) & 1u)) >> 16; }
__device__ __forceinline__ unsigned pk2(float lo, float hi) { return f2bf(lo) | (f2bf(hi) << 16); }
__device__ __forceinline__ float wave_sum(float v) {
#pragma unroll
    for (int o = 1; o < 64; o <<= 1) v += __shfl_xor(v, o);
    return v;
}
__device__ __forceinline__ void tr_load(f32x4 (&v)[16], const float* W, int ld, int col0, int ncv, int item, int nblk, int lane) {
    const int kb = item / nblk, nb = item % nblk, k0 = 64 * kb, n0 = 64 * nb; const int n4 = (lane & 15) * 4; const bool okc = (n0 + n4) < ncv;
#pragma unroll
    for (int i = 0; i < 16; ++i) { const int kk = 4 * i + (lane >> 4); v[i] = okc ? *(const f32x4*)(W + (size_t)(k0 + kk) * ld + col0 + n0 + n4) : (f32x4){0.f, 0.f, 0.f, 0.f}; }
}
__device__ __forceinline__ void tr_store(const f32x4 (&v)[16], int ncv, int K, const float* g, bf16* WT, LAS float* scr, int item, int nblk, int lane) {
    const int kb = item / nblk, nb = item % nblk, k0 = 64 * kb, n0 = 64 * nb; const int n4 = (lane & 15) * 4;
#pragma unroll
    for (int i = 0; i < 16; ++i) { const int kk = 4 * i + (lane >> 4); f32x4 t = v[i]; if (g) t = t * g[k0 + kk]; LAS float* d = scr + kk * 65 + n4; d[0] = t[0]; d[1] = t[1]; d[2] = t[2]; d[3] = t[3]; }
    LDS_WAIT(); asm volatile("" ::: "memory");
    const int cch = lane & 7;
#pragma unroll
    for (int j = 0; j < 8; ++j) { const int n = (lane >> 3) + 8 * j; const LAS float* s = scr + (8 * cch) * 65 + n;
        u32x4 o; o.x = pk2(s[0 * 65], s[1 * 65]); o.y = pk2(s[2 * 65], s[3 * 65]); o.z = pk2(s[4 * 65], s[5 * 65]); o.w = pk2(s[6 * 65], s[7 * 65]);
        if (n0 + n < ncv) *(u32x4*)(WT + (size_t)(n0 + n) * K + k0 + 8 * cch) = o; }
    LDS_WAIT(); asm volatile("" ::: "memory");
}
struct Args { const float* in[14]; float* out; unsigned char* ws; };
struct Mat { const float* W; int ld, col0, ncv, K; const float* g; size_t wt; };

__global__ void __launch_bounds__(NWAVES * 64, 2) fwd_megakernel(Args args) {
    extern __shared__ __attribute__((aligned(16))) unsigned char lds_raw[];
    LAS unsigned char* lds = (LAS unsigned char*)lds_raw;
    cg::grid_group grid = cg::this_grid();
    const int tid = threadIdx.x, lane = tid & 63, wave = __builtin_amdgcn_readfirstlane(tid >> 6);
    const int G = gridDim.x, c = blockIdx.x;
    unsigned char* ws = args.ws;
    volatile LAS unsigned* bst = (volatile LAS unsigned*)(lds + LDS_BYTES - 64);
    if (tid < 16) bst[tid] = 0u;
    __syncthreads();
    (void)xcd_barrier_post((unsigned*)(ws + WS_BAR), bst);
#define GRID_BAR() do { XcdBarrier b_; b_.bar = (unsigned*)(args.ws + WS_BAR); b_.x = xb_xcc_id(); b_.st = (volatile LAS unsigned*)(lds + LDS_BYTES - 64); xcd_barrier(b_); } while (0)
    const float* x = args.in[0];
    float* out = args.out;
    float* SSP = (float*)(ws + WS_SSP); float* LF = (float*)(ws + WS_LF); float* D2 = (float*)(ws + WS_D2); bf16* WfT = (bf16*)(ws + WS_WF);
    bf16* XB = (bf16*)(ws + WS_XB);
    const int gw = c * NWAVES + wave, NGW = G * NWAVES;

#pragma unroll 1
    for (int rep0 = 0; rep0 < REP_P0; ++rep0)
    {
        LAS float* scr = (LAS float*)(lds + wave * 16640);
        const float* mixg = args.in[10]; const float* mlpg = args.in[11];
#pragma unroll 1
        for (int mi = 0; mi < 9; ++mi) {
            Mat M;
            switch (mi) {
                case 0: M = Mat{args.in[1], 6160, 0, 6144, 2048, mixg, WS_FOX_IN}; break;
                case 1: M = Mat{args.in[1], 6160, 6144, 16, 2048, mixg, WS_WF}; break;
                case 2: M = Mat{args.in[5], 2048, 0, 2048, 2048, nullptr, WS_FOX_O}; break;
                case 3: M = Mat{args.in[6], 8192, 0, 8192, 2048, mixg + 2048, WS_DIL_IN}; break;
                case 4: M = Mat{args.in[9], 2048, 0, 2048, 2048, nullptr, WS_DIL_O}; break;
                case 5: M = Mat{args.in[12], 8192, 0, 8192, 2048, mlpg, WS_UP0}; break;
                case 6: M = Mat{args.in[12] + (size_t)2048 * 8192, 8192, 0, 8192, 2048, mlpg + 2048, WS_UP1}; break;
                case 7: M = Mat{args.in[13], 2048, 0, 2048, 8192, nullptr, WS_DN0}; break;
                default: M = Mat{args.in[13] + (size_t)8192 * 2048, 2048, 0, 2048, 8192, nullptr, WS_DN1}; break;
            }
            const int nblk = (M.ncv + 63) / 64, nitems = (M.K / 64) * nblk;
            if (gw < nitems) {
                f32x4 va[16], vb[16];
                tr_load(va, M.W, M.ld, M.col0, M.ncv, gw, nblk, lane);
                for (int itx = gw; itx < nitems; itx += 2 * NGW) {
                    if (itx + NGW < nitems) tr_load(vb, M.W, M.ld, M.col0, M.ncv, itx + NGW, nblk, lane);
                    tr_store(va, M.ncv, M.K, M.g, (bf16*)(ws + M.wt), scr, itx, nblk, lane);
                    if (itx + NGW < nitems) {
                        if (itx + 2 * NGW < nitems) tr_load(va, M.W, M.ld, M.col0, M.ncv, itx + 2 * NGW, nblk, lane);
                        tr_store(vb, M.ncv, M.K, M.g, (bf16*)(ws + M.wt), scr, itx + NGW, nblk, lane);
                    }
                }
            }
        }
        {
            f32x4 v[8], vn[8];
#pragma unroll
            for (int j = 0; j < 8; ++j) v[j] = ((const f32x4*)(x + (size_t)gw * DM) + lane)[64 * j];
            for (int m = gw; m < NTOK; m += NGW) {
                if (m + NGW < NTOK) {
#pragma unroll
                    for (int j = 0; j < 8; ++j) vn[j] = ((const f32x4*)(x + (size_t)(m + NGW) * DM) + lane)[64 * j]; }
                float s = 0.f;
#pragma unroll
                for (int j = 0; j < 8; ++j) s += (v[j][0] * v[j][0] + v[j][1] * v[j][1]) + (v[j][2] * v[j][2] + v[j][3] * v[j][3]);
                s = wave_sum(s);
                if (lane < 8) SSP[(size_t)lane * NTOK + m] = lane == 0 ? s : 0.f;
                u32x2* o8 = (u32x2*)(XB + (size_t)m * DM) + lane;
#pragma unroll
                for (int j = 0; j < 8; ++j) { u32x2 wv; wv.x = pk2(v[j][0], v[j][1]); wv.y = pk2(v[j][2], v[j][3]); o8[64 * j] = wv; }
#pragma unroll
                for (int j = 0; j < 8; ++j) v[j] = vn[j];
            }
        }
    }
    if (args.out == nullptr) grid.sync();
    GRID_BAR();

    bf16* R = (bf16*)(ws + WS_R);
    LAS unsigned char* ex = lds + EX_OFF;
    {
        bf16* Qf = R; bf16* Kf = R + (size_t)NTOK * DM; bf16* Vf = R + (size_t)2 * NTOK * DM; bf16* Of = R + (size_t)3 * NTOK * DM;
        { pg8::Gemm g{XB, (const bf16*)(ws + WS_FOX_IN), NTOK, 6144, 2048}; pg8::StaticOrder S; S.init(NTOK, 6144, G, c);
          pg8::EpiQKV E{Qf, Kf, Vf, 8, 2048, args.in[3], args.in[4], 1 << 20, SSP, ex};
          pg8::epi_rs_invalidate(ex); pg8::gemm_phase<pg8::EpiQKV, pg8::StaticOrder, true, true>(lds, g, S, E); }
        int tf_ = threadIdx.x; asm volatile("" : "+v"(tf_));
        for (int task = c * NWAVES + (tf_ >> 6); task < NTOK / 16; task += NGW) {
            const int lane = tf_ & 63, i16 = lane & 15, kq = lane >> 4, tok = 16 * task + i16;
            const bf16* ap = WfT + (size_t)i16 * DM + 8 * kq; const bf16* bp = XB + (size_t)tok * DM + 8 * kq;
            f32x4 acc = {0.f, 0.f, 0.f, 0.f};
#pragma unroll 1
            for (int s0 = 0; s0 < 64; s0 += 16) {
                bf16x8 fa[16], fb[16];
#pragma unroll
                for (int s = 0; s < 16; ++s) { fa[s] = *(const bf16x8*)(ap + 32 * (s0 + s)); fb[s] = *(const bf16x8*)(bp + 32 * (s0 + s)); }
#pragma unroll
                for (int s = 0; s < 16; ++s) acc = __builtin_amdgcn_mfma_f32_16x16x32_bf16(fa[s], fb[s], acc, 0, 0, 0);
            }
            float ss = 0.f;
#pragma unroll
            for (int i = 0; i < 8; ++i) ss += SSP[(size_t)i * NTOK + tok];
            const float rs = rsqrtf(ss * (1.0f / 2048.0f) + 1e-6f);
#pragma unroll
            for (int r = 0; r < 4; ++r) { const int hh = 4 * kq + r; const float z = acc[r] * rs + args.in[2][hh];
                LF[(size_t)hh * NTOK + tok] = fminf(z, 0.f) - log1pf(__expf(-fabsf(z))); }
        }
        GRID_BAR();
        if (c < 32) {
            int tc_ = threadIdx.x; asm volatile("" : "+v"(tc_)); const int tid = tc_, lane = tc_ & 63, wave = tc_ >> 6;
            const int b = c >> 4, h = c & 15; const float* src = LF + (size_t)h * NTOK + (size_t)b * SEQ + 16 * tid; float* dst = D2 + (size_t)c * SEQ + 16 * tid;
            f32x4 v[4]; float run = 0.f;
#pragma unroll
            for (int j = 0; j < 4; ++j) { v[j] = *(const f32x4*)(src + 4 * j);
#pragma unroll
                for (int e = 0; e < 4; ++e) { run += v[j][e]; v[j][e] = run; } }
            float incl = run;
#pragma unroll
            for (int o = 1; o < 64; o <<= 1) { const float t = __shfl_up(incl, o); if (lane >= o) incl += t; }
            LAS float* wt = (LAS float*)lds;
            if (lane == 63) wt[wave] = incl;
            __syncthreads();
            float pre = incl - run;
            for (int ww = 0; ww < wave; ++ww) pre += wt[ww];
#pragma unroll
            for (int j = 0; j < 4; ++j) { f32x4 o;
#pragma unroll
                for (int e = 0; e < 4; ++e) o[e] = -(v[j][e] + pre) * LOG2E;
                *(f32x4*)(dst + 4 * j) = o; }
        }
        GRID_BAR();
        for (int rep = 0; rep < REP_FOX; ++rep) fox_attn_phase(lds, Qf, Of, Kf, Vf, D2, args.in[3], args.in[4], G, c);
        GRID_BAR();
        { pg8::Gemm g{Of, (const bf16*)(ws + WS_FOX_O), NTOK, 2048, 2048}; pg8::StaticOrder S; S.init(NTOK, 2048, G, c);
          pg8::EpiRes E{XB, nullptr, XB, SSP, ex};
          pg8::gemm_phase<pg8::EpiRes, pg8::StaticOrder, true, true>(lds, g, S, E); }
        GRID_BAR();
    }
#define MLP_BLOCK(UPW, DNW, FINAL) do { \
            { pg8::Gemm g{XB, (const bf16*)(ws + (UPW)), NTOK, 8192, 2048}; pg8::StaticOrder S; S.init(NTOK, 8192, G, c); \
              pg8::EpiUp E{R, SSP, ex}; pg8::epi_rs_invalidate(ex); pg8::gemm_phase<pg8::EpiUp, pg8::StaticOrder, true, true>(lds, g, S, E); } \
            GRID_BAR(); \
            { pg8::Gemm g{R, (const bf16*)(ws + (DNW)), NTOK, 2048, 8192}; pg8::StaticOrder S; S.init(NTOK, 2048, G, c); \
              pg8::EpiRes E{XB, (FINAL) ? out : nullptr, (FINAL) ? nullptr : XB, SSP, ex}; pg8::gemm_phase<pg8::EpiRes, pg8::StaticOrder, true, true>(lds, g, S, E); } \
            if (!(FINAL)) GRID_BAR(); } while (0)
    MLP_BLOCK(WS_UP0, WS_DN0, false);
    {
        bf16* Qd = R; bf16* Kd = R + (size_t)NTOK * 3072; bf16* Vd = R + (size_t)2 * NTOK * 3072; bf16* Od = (bf16*)out;
        { pg8::Gemm g{XB, (const bf16*)(ws + WS_DIL_IN), NTOK, 8192, 2048}; pg8::StaticOrder S; S.init(NTOK, 8192, G, c);
          pg8::EpiQKV E{Qd, Kd, Vd, 12, 3072, args.in[7], args.in[8], 4, SSP, ex};
          pg8::epi_rs_invalidate(ex); pg8::gemm_phase<pg8::EpiQKV, pg8::StaticOrder, true, true>(lds, g, S, E); }
        GRID_BAR();
        for (int rep = 0; rep < REP_DIL; ++rep) dil_attn_phase(lds, Qd, Kd, Vd, Od, args.in[7], args.in[8], G, c);
        GRID_BAR();
        { pg8::Gemm g{Od, (const bf16*)(ws + WS_DIL_O), NTOK, 2048, 2048}; pg8::StaticOrder S; S.init(NTOK, 2048, G, c);
          pg8::EpiRes E{XB, nullptr, XB, SSP, ex};
          pg8::gemm_phase<pg8::EpiRes, pg8::StaticOrder, true, true>(lds, g, S, E); }
        GRID_BAR();
        MLP_BLOCK(WS_UP1, WS_DN1, true);
    }
}

extern "C" void kernel_launch(void* const* d_in, const int* in_sizes, int n_in, void* d_out, int out_size, void* d_ws, size_t ws_size, hipStream_t stream) {
    static int grid = 0;
    if (grid == 0) {
        if (n_in != 14 || ws_size < WS_END) { fprintf(stderr, "kernel_launch: need 14 inputs and >= %zu bytes of workspace (got %d, %zu)\n", (size_t)WS_END, n_in, ws_size); grid = -1; return; }
        int dev = 0, cus = 0, per_cu = 0;
        hipGetDevice(&dev); hipDeviceGetAttribute(&cus, hipDeviceAttributeMultiprocessorCount, dev);
        if (hipFuncSetAttribute((const void*)fwd_megakernel, hipFuncAttributeMaxDynamicSharedMemorySize, LDS_BYTES) != hipSuccess) { fprintf(stderr, "kernel_launch: hipFuncSetAttribute failed\n"); grid = -1; return; }
        if (hipOccupancyMaxActiveBlocksPerMultiprocessor(&per_cu, (const void*)fwd_megakernel, NWAVES * 64, LDS_BYTES) != hipSuccess || per_cu < 1) { fprintf(stderr, "kernel_launch: occupancy query gave %d\n", per_cu); per_cu = 1; }
        (void)hipGetLastError();
        grid = cus * 1;
    }
    if (grid < 0) return;
    if (hipMemsetAsync((char*)d_ws + WS_BAR, 0, 16384, stream) != hipSuccess) { fprintf(stderr, "kernel_launch: memset of the barrier words failed\n"); return; }
    Args a{};
    for (int i = 0; i < 14; ++i) a.in[i] = (const float*)d_in[i];
    a.out = (float*)d_out; a.ws = (unsigned char*)d_ws;
    void* kargs[] = {&a};
    hipError_t e = hipLaunchCooperativeKernel((const void*)fwd_megakernel, dim3(grid), dim3(NWAVES * 64), kargs, LDS_BYTES, stream);
    if (e != hipSuccess) fprintf(stderr, "kernel_launch: cooperative launch failed: %s (grid %d)\n", hipGetErrorString(e), grid);
}
```
